# Optimizing an MI355X kernel written in HIP

```python
import jax, jax.numpy as jnp
from jax import lax
import numpy as np

D_MODEL = 2048
BATCH = 1
SEQ = 8192
DEPTH = 1

GRID_W = 64
MIX_WIDTH = D_MODEL
MLA_HEADS = 8
MLA_NOPE = 128
MLA_ROPE = 64
MLA_V = 128
MLA_Q_RANK = 512
MLA_KV_RANK = 256
ROPE_THETA = 10000.0
NA_HEADS = 8
NA_HEAD_DIM = 128
NA_ROWS_MAX = 8
NA_COLS = 16
D_FF = 4 * D_MODEL
Q_BLOCK = 128
NORM_EPS = 1e-6

MLA_WIDTH = MLA_HEADS * MLA_V
NA_WIDTH = NA_HEADS * NA_HEAD_DIM
MLA_QK = MLA_NOPE + MLA_ROPE
IN_COLS = MLA_Q_RANK + MLA_KV_RANK + MLA_ROPE + 3 * NA_WIDTH

kernel_name = "hybrid_mla_natten_sqrelu_block"


def rms_norm(x, g):
    xf = x.astype(jnp.float32)
    y = xf * lax.rsqrt(jnp.mean(xf * xf, axis=-1, keepdims=True) + NORM_EPS)
    return (y * g.astype(jnp.float32)).astype(x.dtype)


def apply_rope(x, pos):
    half = x.shape[-1] // 2
    inv = ROPE_THETA ** (-jnp.arange(half, dtype=jnp.float32) / half)
    ang = pos.astype(jnp.float32)[:, None] * inv[None, :]
    c = jnp.cos(ang)[None, :, None, :]
    s = jnp.sin(ang)[None, :, None, :]
    xf = x.astype(jnp.float32)
    x1, x2 = xf[..., :half], xf[..., half:]
    return jnp.concatenate([x1 * c - x2 * s, x1 * s + x2 * c], axis=-1).astype(x.dtype)


def mla_mixer(c_q, c_kv, k_rope, q_norm_g, w_uq, kv_norm_g, w_ukv):
    B, S, _ = c_q.shape
    H = MLA_HEADS
    pos = jnp.arange(S)
    q = (rms_norm(c_q, q_norm_g) @ w_uq).reshape(B, S, H, MLA_QK)
    q_nope, q_rope = q[..., :MLA_NOPE], apply_rope(q[..., MLA_NOPE:], pos)
    kv = (rms_norm(c_kv, kv_norm_g) @ w_ukv).reshape(B, S, H, MLA_NOPE + MLA_V)
    k_nope, v = kv[..., :MLA_NOPE], kv[..., MLA_NOPE:]
    k_r = apply_rope(k_rope[:, :, None, :], pos)[:, :, 0, :]
    scale = MLA_QK ** -0.5
    nb = S // Q_BLOCK
    qn_b = q_nope.reshape(B, nb, Q_BLOCK, H, MLA_NOPE).transpose(1, 0, 2, 3, 4)
    qr_b = q_rope.reshape(B, nb, Q_BLOCK, H, MLA_ROPE).transpose(1, 0, 2, 3, 4)

    def block(args):
        qn, qr = args
        s = (jnp.einsum('bqhd,bkhd->bhqk', qn, k_nope, preferred_element_type=jnp.float32)
             + jnp.einsum('bqhr,bkr->bhqk', qr, k_r, preferred_element_type=jnp.float32))
        p = jax.nn.softmax(s * scale, axis=-1).astype(v.dtype)
        return jnp.einsum('bhqk,bkhd->bqhd', p, v)

    o = lax.map(block, (qn_b, qr_b))
    return o.transpose(1, 0, 2, 3, 4).reshape(B, S, MLA_WIDTH)


def na_mixer(q, k, v, rpb):
    B, S, _ = q.shape
    W = GRID_W
    rows = S // W
    kr = min(NA_ROWS_MAX, rows)
    kc = NA_COLS
    H, D = NA_HEADS, NA_HEAD_DIM
    qg = q.reshape(B, rows, W, H, D).transpose(1, 0, 2, 3, 4)
    kg = k.reshape(B, rows, W, H, D)
    vg = v.reshape(B, rows, W, H, D)
    col = jnp.arange(W)
    col_start = jnp.clip(col - kc // 2, 0, W - kc)
    col_idx = col_start[:, None] + jnp.arange(kc)[None, :]
    dc = col_idx - col[:, None] + (NA_COLS - 1)
    scale = D ** -0.5

    def row_block(args):
        r, qr = args
        rs = jnp.clip(r - kr // 2, 0, rows - kr)
        kb = lax.dynamic_slice_in_dim(kg, rs, kr, axis=1)
        vb = lax.dynamic_slice_in_dim(vg, rs, kr, axis=1)
        kw = kb[:, :, col_idx]
        vw = vb[:, :, col_idx]
        dr = rs + jnp.arange(kr) - r + (NA_ROWS_MAX - 1)
        bias = rpb[:, dr[:, None, None], dc[None, :, :]]
        bias = bias.transpose(0, 2, 1, 3).astype(jnp.float32)
        s = jnp.einsum('bchd,bicjhd->bhcij', qr, kw, preferred_element_type=jnp.float32) * scale
        s = (s + bias[None]).reshape(B, H, W, kr * kc)
        p = jax.nn.softmax(s, axis=-1).astype(vw.dtype).reshape(B, H, W, kr, kc)
        return jnp.einsum('bhcij,bicjhd->bchd', p, vw)

    o = lax.map(row_block, (jnp.arange(rows), qg))
    return o.transpose(1, 0, 2, 3, 4).reshape(B, S, NA_WIDTH)


def setup_inputs(seed: int = 0) -> dict:
    key = jax.random.key(seed)
    ks = jax.random.split(key, 20)
    f32 = jnp.float32

    def nrm(k, shape, scale):
        return jax.random.normal(k, shape, f32) * scale

    def gain(k, n):
        return 1.0 + 0.02 * jax.random.normal(k, (DEPTH, n), f32)

    return {
        "x": jax.random.normal(ks[0], (BATCH, SEQ, D_MODEL), f32),
        "attn_norm_g": gain(ks[1], D_MODEL),
        "w_in": nrm(ks[2], (DEPTH, D_MODEL, IN_COLS), D_MODEL ** -0.5),
        "q_norm_g": gain(ks[3], MLA_Q_RANK),
        "w_uq": nrm(ks[4], (DEPTH, MLA_Q_RANK, MLA_HEADS * MLA_QK), MLA_Q_RANK ** -0.5),
        "kv_norm_g": gain(ks[5], MLA_KV_RANK),
        "w_ukv": nrm(ks[6], (DEPTH, MLA_KV_RANK, MLA_HEADS * (MLA_NOPE + MLA_V)), MLA_KV_RANK ** -0.5),
        "na_rpb": nrm(ks[7], (DEPTH, NA_HEADS, 2 * NA_ROWS_MAX - 1, 2 * NA_COLS - 1), 0.5),
        "mla_out_norm_g": gain(ks[8], MLA_WIDTH),
        "na_out_norm_g": gain(ks[9], NA_WIDTH),
        "w_out": nrm(ks[10], (DEPTH, MIX_WIDTH, D_MODEL), MIX_WIDTH ** -0.5),
        "mlp_norm_g": gain(ks[11], D_MODEL),
        "w_ff1": nrm(ks[12], (DEPTH, D_MODEL, D_FF), D_MODEL ** -0.5),
        "w_ff2": nrm(ks[13], (DEPTH, D_FF, D_MODEL), (1.5 * D_FF) ** -0.5),
        "final_norm_g": 1.0 + 0.02 * jax.random.normal(ks[14], (D_MODEL,), f32),
    }


def reference(x, attn_norm_g, w_in, q_norm_g, w_uq, kv_norm_g, w_ukv, na_rpb,
              mla_out_norm_g, na_out_norm_g, w_out, mlp_norm_g, w_ff1, w_ff2,
              final_norm_g):
    splits = np.cumsum([MLA_Q_RANK, MLA_KV_RANK, MLA_ROPE, NA_WIDTH, NA_WIDTH]).tolist()
    for l in range(DEPTH):
        h = rms_norm(x, attn_norm_g[l])
        z = h @ w_in[l]
        c_q, c_kv, k_rope, na_q, na_k, na_v = jnp.split(z, splits, axis=-1)
        a_out = mla_mixer(c_q, c_kv, k_rope, q_norm_g[l], w_uq[l], kv_norm_g[l], w_ukv[l])
        n_out = na_mixer(na_q, na_k, na_v, na_rpb[l])
        mixed = jnp.concatenate([rms_norm(a_out, mla_out_norm_g[l]),
                                 rms_norm(n_out, na_out_norm_g[l])], axis=-1)
        x = x + mixed @ w_out[l]
        h = rms_norm(x, mlp_norm_g[l])
        x = x + jnp.square(jax.nn.relu(h @ w_ff1[l])) @ w_ff2[l]
    return rms_norm(x, final_norm_g)
```

```cpp
#include <hip/hip_runtime.h>
#include <hip/hip_cooperative_groups.h>
#include <hip/hip_bf16.h>
#include <cstdio>
#include <cstdint>
#include <cmath>
namespace cg = cooperative_groups;

#ifndef MK_N_LAUNCHES
#define MK_N_LAUNCHES 1
#endif

namespace pg8 {
#define PG8_LAS __attribute__((address_space(3)))
typedef unsigned short bf16_t;
typedef short bf16x8 __attribute__((ext_vector_type(8)));
typedef float f32x4 __attribute__((ext_vector_type(4)));
typedef float f32x2 __attribute__((ext_vector_type(2)));
typedef unsigned u32x4 __attribute__((ext_vector_type(4)));
typedef unsigned u32x2 __attribute__((ext_vector_type(2)));
constexpr int BM = 256, BK = 64, HALF = 128, HTB = HALF * BK * 2  , STAGE_BYTES = 8 * HTB, NXCD = 8, WGM = 8;

__host__ __device__ __forceinline__ int lds_byte(int r, int c) { const int st = (r >> 4) * 2 + (c >> 5), rr = r & 15, cc = c & 31, ob = rr * 64 + cc * 2; return st * 1024 + (ob ^ (((ob >> 9) & 1) << 5)); }
__host__ __device__ __forceinline__ void stage_rc(int b, int& R, int& C) { const int st = b / 1024, sb = b % 1024, swz = sb ^ (((sb >> 9) & 1) << 5); R = (st >> 1) * 16 + swz / 64; C = (st & 1) * 32 + (swz % 64) / 2; }
__host__ __device__ __forceinline__ int perm32(int rho) { const int n = rho >> 4, i = rho & 15; return 8 * (i >> 2) + 4 * n + (i & 3); }

struct Unit { int pm, pn; };
struct Gemm { const bf16_t* A; const bf16_t* Bt; int M, N, K, lda, ldb; };

struct StaticOrder {
    int nM, nN, nwg, G, c;
    __host__ __device__ void init(int M, int N, int G_, int c_) { nM = M / BM; nN = N / BM; nwg = nM * nN; G = G_; c = c_; }
    __host__ __device__ bool next(int i, Unit& u) const {
        const long L = (long)i * G + c; if (L >= nwg) return false;
        int wgid = (int)L; { const int q = nwg / NXCD, r = nwg % NXCD, xcd = wgid % NXCD, off = wgid / NXCD; wgid = (xcd < r ? xcd * (q + 1) : r * (q + 1) + (xcd - r) * q) + off; }
        const int nig = WGM * nN, gid = wgid / nig, fm = gid * WGM, gsz = (nM - fm) < WGM ? (nM - fm) : WGM;
        u.pm = fm + ((wgid % nig) % gsz); u.pn = (wgid % nig) / gsz; return true;
    }
    __device__ __forceinline__ void a_ready(const Unit&) const {}
    __device__ __forceinline__ void done(const Unit&) const {}
};

struct OneUnit { Unit u;
    __device__ __forceinline__ bool next(int i, Unit& o) const { if (i != 0) return false; o = u; return true; }
    __device__ __forceinline__ void a_ready(const Unit&) const {}
    __device__ __forceinline__ void done(const Unit&) const {}
};

__device__ __forceinline__ unsigned cvt_pk_bf16(float lo, float hi) { unsigned r; asm volatile("v_cvt_pk_bf16_f32 %0, %1, %2" : "=v"(r) : "v"(lo), "v"(hi)); return r; }
constexpr float NORM_EPS = 1e-6f;

__device__ __forceinline__ u32x4 pack8(f32x4 v0, f32x4 v1) { u32x4 w; w.x = cvt_pk_bf16(v0[0], v0[1]); w.y = cvt_pk_bf16(v0[2], v0[3]); w.z = cvt_pk_bf16(v1[0], v1[1]); w.w = cvt_pk_bf16(v1[2], v1[3]); return w; }
__device__ __forceinline__ float dot4(f32x4 v) { return (v[0] * v[0] + v[1] * v[1]) + (v[2] * v[2] + v[3] * v[3]); }

struct EpiZ {
    static constexpr bool PERM = true, AFTER_DRAIN = false;
    bf16_t* Z; float* ssq;
    __device__ __forceinline__ void operator()(const f32x4 (&acc)[2][2][4][2], const Unit& u, int wr, int wc, int fr, int fq) const {
        const int row0 = u.pm * BM + wr * 64 + fr, col0 = u.pn * BM + wc * 32 + 8 * fq;
#pragma unroll
        for (int ai = 0; ai < 2; ++ai)
#pragma unroll
            for (int m = 0; m < 4; ++m) { const int row = row0 + ai * HALF + m * 16; bf16_t* rowp = Z + (size_t)row * 4096 + col0; float s = 0.f;
#pragma unroll
                for (int bj = 0; bj < 2; ++bj) { const f32x4 v0 = acc[ai][bj][m][0], v1 = acc[ai][bj][m][1]; s += dot4(v0) + dot4(v1); *(u32x4*)(rowp + bj * HALF) = pack8(v0, v1); }
                if (u.pn < 3) { s += __shfl_xor(s, 16); s += __shfl_xor(s, 32); if (fq == 0) ssq[(size_t)row * 12 + u.pn * 4 + wc] = s; } }
    }
};
struct EpiQ {
    static constexpr bool PERM = true, AFTER_DRAIN = false;
    bf16_t* Q; const float* ssq; const float* cs;
    __device__ __forceinline__ void operator()(const f32x4 (&acc)[2][2][4][2], const Unit& u, int wr, int wc, int fr, int fq) const {
        const int row0 = u.pm * BM + wr * 64 + fr, col0 = u.pn * BM + wc * 32 + 8 * fq;
#pragma unroll
        for (int ai = 0; ai < 2; ++ai)
#pragma unroll
            for (int m = 0; m < 4; ++m) { const int row = row0 + ai * HALF + m * 16;
                const f32x4 sa = *(const f32x4*)(ssq + (size_t)row * 12), sb = *(const f32x4*)(ssq + (size_t)row * 12 + 4);
                const float rstd = 1.0f / sqrtf(((sa[0] + sa[1]) + (sa[2] + sa[3]) + (sb[0] + sb[1]) + (sb[2] + sb[3])) * (1.0f / 512.0f) + NORM_EPS);
#pragma unroll
                for (int bj = 0; bj < 2; ++bj) { f32x4 v0 = acc[ai][bj][m][0] * rstd, v1 = acc[ai][bj][m][1] * rstd; const int colg = col0 + bj * HALF; bf16_t* dst;
                    if (u.pn >= 4) { const int cr = colg - 1024, head = cr >> 6, jj = cr & 63;
                        const f32x4 c0 = *(const f32x4*)(cs + (size_t)row * 64 + jj), c1 = *(const f32x4*)(cs + (size_t)row * 64 + jj + 4);
                        f32x4 w0, w1;
                        w0[0] = v0[0] * c0[0] - v0[1] * c0[1]; w0[1] = v0[0] * c0[1] + v0[1] * c0[0]; w0[2] = v0[2] * c0[2] - v0[3] * c0[3]; w0[3] = v0[2] * c0[3] + v0[3] * c0[2];
                        w1[0] = v1[0] * c1[0] - v1[1] * c1[1]; w1[1] = v1[0] * c1[1] + v1[1] * c1[0]; w1[2] = v1[2] * c1[2] - v1[3] * c1[3]; w1[3] = v1[2] * c1[3] + v1[3] * c1[2];
                        v0 = w0; v1 = w1; dst = Q + (size_t)row * 1536 + head * 192 + 128 + jj; }
                    else { const int head = colg >> 7, d = colg & 127; dst = Q + (size_t)row * 1536 + head * 192 + d; }
                    *(u32x4*)dst = pack8(v0, v1); } }
    }
};
struct EpiKV {
    static constexpr bool PERM = true, AFTER_DRAIN = false;
    bf16_t* KV; const float* ssq;
    __device__ __forceinline__ void operator()(const f32x4 (&acc)[2][2][4][2], const Unit& u, int wr, int wc, int fr, int fq) const {
        const int row0 = u.pm * BM + wr * 64 + fr, col0 = u.pn * BM + wc * 32 + 8 * fq;
#pragma unroll
        for (int ai = 0; ai < 2; ++ai)
#pragma unroll
            for (int m = 0; m < 4; ++m) { const int row = row0 + ai * HALF + m * 16;
                const f32x4 sa = *(const f32x4*)(ssq + (size_t)row * 12 + 8);
                const float rstd = 1.0f / sqrtf(((sa[0] + sa[1]) + (sa[2] + sa[3])) * (1.0f / 256.0f) + NORM_EPS);
                bf16_t* rowp = KV + (size_t)row * 2048 + col0;
#pragma unroll
                for (int bj = 0; bj < 2; ++bj) *(u32x4*)(rowp + bj * HALF) = pack8(acc[ai][bj][m][0] * rstd, acc[ai][bj][m][1] * rstd); }
    }
};
struct EpiFF1 {
    static constexpr bool PERM = true, AFTER_DRAIN = false;
    bf16_t* U; const float* ssq2;
    __device__ __forceinline__ void operator()(const f32x4 (&acc)[2][2][4][2], const Unit& u, int wr, int wc, int fr, int fq) const {
        const int row0 = u.pm * BM + wr * 64 + fr, col0 = u.pn * BM + wc * 32 + 8 * fq;
#pragma unroll
        for (int ai = 0; ai < 2; ++ai)
#pragma unroll
            for (int m = 0; m < 4; ++m) { const int row = row0 + ai * HALF + m * 16;
                const f32x4 sa = *(const f32x4*)(ssq2 + (size_t)row * 8), sb = *(const f32x4*)(ssq2 + (size_t)row * 8 + 4);
                const float rstd = 1.0f / sqrtf(((sa[0] + sa[1]) + (sa[2] + sa[3]) + (sb[0] + sb[1]) + (sb[2] + sb[3])) * (1.0f / 2048.0f) + NORM_EPS);
                bf16_t* rowp = U + (size_t)row * 8192 + col0;
#pragma unroll
                for (int bj = 0; bj < 2; ++bj) { f32x4 v0 = acc[ai][bj][m][0] * rstd, v1 = acc[ai][bj][m][1] * rstd;
#pragma unroll
                    for (int j = 0; j < 4; ++j) { const float a = fmaxf(v0[j], 0.f), b = fmaxf(v1[j], 0.f); v0[j] = a * a; v1[j] = b * b; }
                    *(u32x4*)(rowp + bj * HALF) = pack8(v0, v1); } }
    }
};
template <bool WRITE_B> struct EpiRes {
    static constexpr bool PERM = false, AFTER_DRAIN = true;
    const float* base; float* out; bf16_t* xb; float* ssq;
    __device__ __forceinline__ void fused(f32x4 (&acc)[2][2][4][2], const Unit& u, int wr, int wc, int fr, int fq, PG8_LAS unsigned char* lds, int wid, int lane) const {
        PG8_LAS float* P = (PG8_LAS float*)lds;
        const int col0 = u.pn * BM + wc * 32 + 4 * fq;
#pragma unroll
        for (int ai = 0; ai < 2; ++ai)
#pragma unroll
            for (int m = 0; m < 4; ++m) { const int r = ai * HALF + wr * 64 + m * 16 + fr; const size_t off = (size_t)(u.pm * BM + r) * 2048 + col0; float s = 0.f;
#pragma unroll
                for (int bj = 0; bj < 2; ++bj)
#pragma unroll
                    for (int n = 0; n < 2; ++n) { const f32x4 v = *(const f32x4*)(base + off + bj * HALF + n * 16) + acc[ai][bj][m][n]; s += dot4(v);
                        *(f32x4*)(out + off + bj * HALF + n * 16) = v;
                        if (WRITE_B) { u32x2 w; w.x = cvt_pk_bf16(v[0], v[1]); w.y = cvt_pk_bf16(v[2], v[3]); *(u32x2*)(xb + off + bj * HALF + n * 16) = w; } }
                s += __shfl_xor(s, 16); s += __shfl_xor(s, 32);
                if (fq == 0) P[r * 4 + wc] = s;
                if (m & 1) asm volatile("" ::: "memory"); }
        asm volatile("s_waitcnt lgkmcnt(0)" ::: "memory"); __builtin_amdgcn_s_barrier(); asm volatile("" ::: "memory");
        const int t = wid * 64 + lane;
        if (t < 256) ssq[(size_t)(u.pm * BM + t) * 8 + u.pn] = (P[t * 4 + 0] + P[t * 4 + 1]) + (P[t * 4 + 2] + P[t * 4 + 3]);
        asm volatile("s_waitcnt lgkmcnt(0)" ::: "memory"); __builtin_amdgcn_s_barrier(); asm volatile("" ::: "memory");
    }
};

template <class Epi, class Sched, bool ALIGN_EPI = false, bool SP2 = false>
__device__ __forceinline__ void gemm_phase(PG8_LAS unsigned char* lds, const Gemm g, const Sched& S, const Epi& E) {
    const int tid = threadIdx.x, wid = __builtin_amdgcn_readfirstlane(tid >> 6), lane = tid & 63, wr = wid >> 2, wc = wid & 3, fr = lane & 15, fq = lane >> 4;
    const int K = g.K, nt = K / BK;
    unsigned voffA[2], voffB[2];
#pragma unroll
    for (int i = 0; i < 2; ++i) { int R, C; stage_rc(tid * 16 + i * 8192, R, C); const int Rb = Epi::PERM ? ((R & ~31) + perm32(R & 31)) : R;
        voffA[i] = (unsigned)(R * g.lda + C) * 2u; voffB[i] = (unsigned)(Rb * g.ldb + C) * 2u; }
    const size_t kstep = (size_t)(BK * 2);
    const size_t hstepA = (size_t)HALF * g.lda * 2, hstepB = (size_t)HALF * g.ldb * 2;
    const size_t tstepA = 2 * hstepA, tstepB = 2 * hstepB;
    const unsigned ldsw = (unsigned)wid * 1024u;
    const int aoff = lds_byte(wr * 64 + fr, fq * 8), boff = lds_byte(wc * 32 + fr, fq * 8);
#define PG8_SA(b, h) (((b) * 2 + (h)) * HTB)
#define PG8_SB(b, h) ((4 + (b) * 2 + (h)) * HTB)
#define PG8_STAGE(bufoff, gbase, voff) do { _Pragma("unroll") for (int _i = 0; _i < 2; ++_i) \
        __builtin_amdgcn_global_load_lds((const unsigned*)((const char*)(gbase) + (voff)[_i]), (PG8_LAS unsigned*)(lds + (bufoff) + ldsw + _i * 8192), 16, 0, 0); } while (0)
#define PG8_LDA(dst, b, h) do { _Pragma("unroll") for (int m = 0; m < 4; ++m) _Pragma("unroll") for (int k = 0; k < 2; ++k) dst[m][k] = *(const PG8_LAS bf16x8*)(lds + PG8_SA(b, h) + aoff + m * 2048 + k * 1024); } while (0)
#define PG8_LDB(dst, b, h) do { _Pragma("unroll") for (int n = 0; n < 2; ++n) _Pragma("unroll") for (int k = 0; k < 2; ++k) dst[n][k] = *(const PG8_LAS bf16x8*)(lds + PG8_SB(b, h) + boff + n * 2048 + k * 1024); } while (0)
#define PG8_MMA(ai, bj, At, Bt) do { __builtin_amdgcn_s_setprio(1); _Pragma("unroll") for (int m = 0; m < 4; ++m) _Pragma("unroll") for (int n = 0; n < 2; ++n) _Pragma("unroll") for (int k = 0; k < 2; ++k) \
        acc[ai][bj][m][n] = __builtin_amdgcn_mfma_f32_16x16x32_bf16(Bt[n][k], At[m][k], acc[ai][bj][m][n], 0, 0, 0); __builtin_amdgcn_s_setprio(0); } while (0)
#define PG8_WAIT_V(n) asm volatile("s_waitcnt vmcnt(" #n ")" ::: "memory")
#define PG8_WAIT_L(n) asm volatile("s_waitcnt lgkmcnt(" #n ")" ::: "memory")
#define PG8_BAR __builtin_amdgcn_s_barrier()
#define PG8_SCHED __builtin_amdgcn_sched_barrier(0)
    Unit cur, nxt; int ui = 0;
    if (!S.next(0, cur)) return;
    f32x4 acc[2][2][4][2];
#pragma unroll
    for (int a = 0; a < 2; ++a)
#pragma unroll
        for (int b = 0; b < 2; ++b)
#pragma unroll
            for (int m = 0; m < 4; ++m)
#pragma unroll
                for (int n = 0; n < 2; ++n) acc[a][b][m][n] = (f32x4){0.f, 0.f, 0.f, 0.f};
    bf16x8 At[4][2], B0[2][2], B1[2][2];
    const char* cA = (const char*)g.A + (size_t)cur.pm * tstepA; const char* cB = (const char*)g.Bt + (size_t)cur.pn * tstepB;
    S.a_ready(cur);
    if constexpr (SP2) {
        PG8_STAGE(PG8_SB(0, 0), cB, voffB); PG8_STAGE(PG8_SB(0, 1), cB + hstepB, voffB); PG8_STAGE(PG8_SA(0, 0), cA, voffA); PG8_STAGE(PG8_SA(0, 1), cA + hstepA, voffA);
        if (wr == 1) PG8_BAR;
        PG8_WAIT_V(2); PG8_BAR;
        PG8_STAGE(PG8_SB(1, 0), cB + kstep, voffB); PG8_STAGE(PG8_SA(1, 0), cA + kstep, voffA); PG8_STAGE(PG8_SB(1, 1), cB + hstepB + kstep, voffB);
        PG8_WAIT_V(6); PG8_BAR;
    } else {
        PG8_STAGE(PG8_SB(0, 0), cB, voffB); PG8_STAGE(PG8_SA(0, 0), cA, voffA); PG8_STAGE(PG8_SB(0, 1), cB + hstepB, voffB); PG8_STAGE(PG8_SA(0, 1), cA + hstepA, voffA);
        if (wr == 1) PG8_BAR;
        PG8_WAIT_V(4); PG8_BAR;
        PG8_STAGE(PG8_SB(1, 0), cB + kstep, voffB); PG8_STAGE(PG8_SA(1, 0), cA + kstep, voffA); PG8_STAGE(PG8_SB(1, 1), cB + hstepB + kstep, voffB);
        PG8_WAIT_V(6); PG8_BAR;
    }
    for (;;) {
        const bool has_next = S.next(ui + 1, nxt);
        const char* nA = has_next ? (const char*)g.A + (size_t)nxt.pm * tstepA : cA; const char* nB = has_next ? (const char*)g.Bt + (size_t)nxt.pn * tstepB : cB;
        for (int t = 0; t < nt; t += 2) {
            const bool last = (t == nt - 2);
            const char* a1 = cA + (size_t)(t + 1) * kstep;
            const char* a2 = last ? nA : cA + (size_t)(t + 2) * kstep; const char* b2 = last ? nB : cB + (size_t)(t + 2) * kstep;
            const char* a3 = a2 + kstep; const char* b3 = b2 + kstep;
            if (last && has_next) S.a_ready(nxt);
            if constexpr (SP2) {
            PG8_LDB(B0, 0, 0); PG8_LDB(B1, 0, 1); PG8_SCHED; PG8_LDA(At, 0, 0); PG8_STAGE(PG8_SA(1, 1), a1 + hstepA, voffA);
            PG8_WAIT_V(8); PG8_WAIT_L(0); PG8_BAR; PG8_MMA(0, 0, At, B0); PG8_MMA(0, 1, At, B1); PG8_BAR; PG8_SCHED;
            PG8_LDA(At, 0, 1); PG8_STAGE(PG8_SB(0, 0), b2, voffB); PG8_STAGE(PG8_SB(0, 1), b2 + hstepB, voffB); PG8_STAGE(PG8_SA(0, 0), a2, voffA);
            PG8_WAIT_V(8); PG8_WAIT_L(0); PG8_BAR; PG8_MMA(1, 0, At, B0); PG8_MMA(1, 1, At, B1); PG8_BAR; PG8_SCHED;
            PG8_LDB(B0, 1, 0); PG8_LDB(B1, 1, 1); PG8_SCHED; PG8_LDA(At, 1, 0); PG8_STAGE(PG8_SA(0, 1), a2 + hstepA, voffA);
            PG8_WAIT_V(8); PG8_WAIT_L(0); PG8_BAR; PG8_MMA(0, 0, At, B0); PG8_MMA(0, 1, At, B1); PG8_BAR; PG8_SCHED;
            PG8_LDA(At, 1, 1); PG8_STAGE(PG8_SB(1, 0), b3, voffB); PG8_STAGE(PG8_SB(1, 1), b3 + hstepB, voffB); PG8_STAGE(PG8_SA(1, 0), a3, voffA);
            PG8_WAIT_V(8); PG8_WAIT_L(0); PG8_BAR; PG8_MMA(1, 0, At, B0); PG8_MMA(1, 1, At, B1); PG8_BAR; PG8_SCHED;
            } else {
            PG8_LDB(B0, 0, 0); PG8_SCHED; PG8_LDA(At, 0, 0); PG8_STAGE(PG8_SA(1, 1), a1 + hstepA, voffA);
            PG8_WAIT_L(8); PG8_BAR; PG8_WAIT_L(0); PG8_MMA(0, 0, At, B0); PG8_BAR; PG8_SCHED;
            PG8_LDB(B1, 0, 1); PG8_STAGE(PG8_SB(0, 0), b2, voffB);
            PG8_BAR; PG8_WAIT_L(0); PG8_MMA(0, 1, At, B1); PG8_BAR;
            PG8_LDA(At, 0, 1); PG8_STAGE(PG8_SA(0, 0), a2, voffA);
            PG8_BAR; PG8_WAIT_L(0); PG8_MMA(1, 0, At, B0); PG8_BAR; PG8_SCHED;
            PG8_STAGE(PG8_SB(0, 1), b2 + hstepB, voffB);
            PG8_WAIT_V(6); PG8_BAR; PG8_MMA(1, 1, At, B1); PG8_BAR;
            PG8_LDB(B0, 1, 0); PG8_SCHED; PG8_LDA(At, 1, 0); PG8_STAGE(PG8_SA(0, 1), a2 + hstepA, voffA);
            PG8_WAIT_L(8); PG8_BAR; PG8_WAIT_L(0); PG8_MMA(0, 0, At, B0); PG8_BAR; PG8_SCHED;
            PG8_LDB(B1, 1, 1); PG8_STAGE(PG8_SB(1, 0), b3, voffB);
            PG8_BAR; PG8_WAIT_L(0); PG8_MMA(0, 1, At, B1); PG8_BAR;
            PG8_LDA(At, 1, 1); PG8_STAGE(PG8_SA(1, 0), a3, voffA);
            PG8_BAR; PG8_WAIT_L(0); PG8_MMA(1, 0, At, B0); PG8_BAR; PG8_SCHED;
            PG8_STAGE(PG8_SB(1, 1), b3 + hstepB, voffB);
            PG8_WAIT_V(6); PG8_BAR; PG8_MMA(1, 1, At, B1); PG8_BAR;
            }
        }
        if constexpr (ALIGN_EPI) { if (wr == 0) PG8_BAR; }
        if constexpr (!Epi::AFTER_DRAIN) { E(acc, cur, wr, wc, fr, fq); S.done(cur); }
        if (!has_next) break;
#pragma unroll
        for (int a = 0; a < 2; ++a)
#pragma unroll
            for (int b = 0; b < 2; ++b)
#pragma unroll
                for (int m = 0; m < 4; ++m)
#pragma unroll
                    for (int n = 0; n < 2; ++n) acc[a][b][m][n] = (f32x4){0.f, 0.f, 0.f, 0.f};
        cur = nxt; cA = nA; cB = nB; ++ui;
        if constexpr (ALIGN_EPI) { if (wr == 1) PG8_BAR; }
    }
    PG8_WAIT_V(0);
    if constexpr (!ALIGN_EPI) { if (wr == 0) PG8_BAR; }
    PG8_BAR;
    if constexpr (Epi::AFTER_DRAIN) { E.fused(acc, cur, wr, wc, fr, fq, lds, wid, lane); S.done(cur); }
#undef PG8_SA
#undef PG8_SB
#undef PG8_STAGE
#undef PG8_LDA
#undef PG8_LDB
#undef PG8_MMA
#undef PG8_WAIT_V
#undef PG8_WAIT_L
#undef PG8_BAR
#undef PG8_SCHED
}
}
namespace att {
using bf16 = unsigned short;
using bf16x8 = __attribute__((ext_vector_type(8))) short;
using s16x4  = __attribute__((ext_vector_type(4))) short;
using f32x16 = __attribute__((ext_vector_type(16))) float;
using u32x4  = __attribute__((ext_vector_type(4))) unsigned;
constexpr int NW = 8, QBLK = 32, KVBLK = 64, DV = 128;
constexpr float THR = 8.f;
constexpr int SHM_V = KVBLK * DV * 2;
constexpr int SHM_KMAX = KVBLK * 192 * 2;
#ifndef ATT_QLDS
#define ATT_QLDS 0
#endif
constexpr int OFF_V = 0, OFF_K = 2 * SHM_V, OFF_WS = OFF_K + 2 * SHM_KMAX, OFF_BIAS = OFF_WS + NW * 64 * 4, OFF_QL = OFF_BIAS + 4096, ATTN_LDS_BYTES = OFF_QL + NW * ATT_QLDS * 1024;
#define SBAR() __builtin_amdgcn_sched_barrier(0)
__device__ __forceinline__ int crow(int r, int hi) { return (r & 3) + 8 * (r >> 2) + 4 * hi; }
__device__ __forceinline__ unsigned cvtpk(float lo, float hi) { unsigned r; asm volatile("v_cvt_pk_bf16_f32 %0, %1, %2" : "=v"(r) : "v"(lo), "v"(hi)); return r; }
__device__ __forceinline__ bf16x8 ld8(const bf16* p) { return *reinterpret_cast<const bf16x8*>(p); }

template <int MODE> struct Cfg {
    static constexpr int DQ = MODE == 0 ? 192 : 128, ND0 = DQ / 16, KPITCH = DQ * 2, SHM_K = KVBLK * KPITCH;
    static constexpr float SCALE = MODE == 0 ? 0.07216878364870322f : 1.0f;
};
constexpr float NA_SCALE = 0.08838834764831845f;

template <int MODE>
__device__ __forceinline__ void partialSM(f32x16& p0, f32x16& p1, float& m_reg, float& mn, float& alpha) {
  constexpr float SC = Cfg<MODE>::SCALE, C = SC * 1.4426950408889634f;
  float pmax = p0[0];
#pragma unroll
  for (int r = 1; r < 16; ++r) pmax = fmaxf(pmax, p0[r]);
#pragma unroll
  for (int r = 0; r < 16; ++r) pmax = fmaxf(pmax, p1[r]);
  { auto rr = __builtin_amdgcn_permlane32_swap(__float_as_uint(pmax), __float_as_uint(pmax), false, false);
    pmax = fmaxf(__uint_as_float(rr[0]), __uint_as_float(rr[1])); }
  if (__builtin_expect(__all(pmax - m_reg <= THR / SC), 1)) { mn = m_reg; alpha = 1.f; }
  else { mn = fmaxf(m_reg, pmax); alpha = __builtin_amdgcn_exp2f((m_reg - mn) * C); m_reg = mn; }
  float mnC = -mn * C;
#pragma unroll
  for (int r = 0; r < 16; ++r) p0[r] = fmaf(p0[r], C, mnC);
#pragma unroll
  for (int r = 0; r < 16; ++r) p1[r] = fmaf(p1[r], C, mnC);
#pragma unroll
  for (int r = 0; r < 16; ++r) p0[r] = __builtin_amdgcn_exp2f(p0[r]);
}
__device__ __forceinline__ void finishSM(f32x16& p0, f32x16& p1, float alpha, float& l_reg, bf16x8& pa0, bf16x8& pa1, bf16x8& pa2, bf16x8& pa3) {
#pragma unroll
  for (int r = 0; r < 16; ++r) p1[r] = __builtin_amdgcn_exp2f(p1[r]);
  float ps = 0;
#pragma unroll
  for (int r = 0; r < 16; ++r) ps += p0[r];
#pragma unroll
  for (int r = 0; r < 16; ++r) ps += p1[r];
  { auto rr = __builtin_amdgcn_permlane32_swap(__float_as_uint(ps), __float_as_uint(ps), false, false);
    ps = __uint_as_float(rr[0]) + __uint_as_float(rr[1]); }
  l_reg = l_reg * alpha + ps;
#define PK4(P, BASE, OUT) do { unsigned a0 = cvtpk(P[BASE + 0], P[BASE + 1]), a1 = cvtpk(P[BASE + 2], P[BASE + 3]);   \
    unsigned b0 = cvtpk(P[BASE + 4], P[BASE + 5]), b1 = cvtpk(P[BASE + 6], P[BASE + 7]);                              \
    auto r0 = __builtin_amdgcn_permlane32_swap(a0, b0, false, false); auto r1 = __builtin_amdgcn_permlane32_swap(a1, b1, false, false); \
    u32x4 w = {r0[0], r1[0], r0[1], r1[1]}; OUT = *reinterpret_cast<bf16x8*>(&w); } while (0)
  PK4(p0, 0, pa0); PK4(p0, 8, pa1); PK4(p1, 0, pa2); PK4(p1, 8, pa3);
#undef PK4
}
template <int MODE>
__device__ __forceinline__ void qkt(f32x16& p0, f32x16& p1, const char* Ks, const bf16x8* qr, const char* ql, int r32, int hi) {
  constexpr int NREG = MODE == 0 ? Cfg<MODE>::ND0 - ATT_QLDS : Cfg<MODE>::ND0;
  constexpr int KP = Cfg<MODE>::KPITCH;
  p0 = f32x16{}; p1 = f32x16{};
#pragma unroll
  for (int d0 = 0; d0 < Cfg<MODE>::ND0; ++d0) { const int cb = (d0 * 16 + hi * 8) * 2;
    bf16x8 b0 = *reinterpret_cast<const bf16x8*>(Ks + r32 * KP + (cb ^ ((r32 & 7) << 4)));
    bf16x8 b1 = *reinterpret_cast<const bf16x8*>(Ks + (32 + r32) * KP + (cb ^ ((r32 & 7) << 4)));
    const bf16x8 qv = d0 < NREG ? qr[d0 < NREG ? d0 : 0] : *reinterpret_cast<const bf16x8*>(ql + (d0 - NREG) * 1024);
    p0 = __builtin_amdgcn_mfma_f32_32x32x16_bf16(b0, qv, p0, 0, 0, 0);
    p1 = __builtin_amdgcn_mfma_f32_32x32x16_bf16(b1, qv, p1, 0, 0, 0); }
}
__device__ __forceinline__ int v_st(int k, int c) { const int kk = (k & ~0xC) | ((k & 4) << 1) | ((k & 8) >> 1); return ((kk >> 3) * 4 + (c >> 5)) * 512 + ((kk & 7) * 32 + (c & 31)) * 2; }
__device__ __forceinline__ int v_rd_base(int lane) { return ((lane & 3) << 3) | (((lane >> 2) & 3) << 6) | (((lane >> 4) & 1) << 5) | (((lane >> 5) & 1) << 8); }
constexpr int v_rd_off(int d0, int ks, int half) { return d0 * 512 + ks * 4096 + half * 2048; }
template <int OFF> __device__ __forceinline__ s16x4 tr_read(int vb) {
  s16x4 r; asm volatile("ds_read_b64_tr_b16 %0, %1 offset:%2" : "=&v"(r) : "v"(vb), "i"(OFF) : "memory"); return r;
}
template <int D0> __device__ __forceinline__ void pv_one(f32x16& od, int vb, bf16x8 pa0, bf16x8 pa1, bf16x8 pa2, bf16x8 pa3) {
  const s16x4 l0 = tr_read<v_rd_off(D0, 0, 0)>(vb), h0 = tr_read<v_rd_off(D0, 0, 1)>(vb), l1 = tr_read<v_rd_off(D0, 1, 0)>(vb), h1 = tr_read<v_rd_off(D0, 1, 1)>(vb);
  const s16x4 l2 = tr_read<v_rd_off(D0, 2, 0)>(vb), h2 = tr_read<v_rd_off(D0, 2, 1)>(vb), l3 = tr_read<v_rd_off(D0, 3, 0)>(vb), h3 = tr_read<v_rd_off(D0, 3, 1)>(vb);
  asm volatile("s_waitcnt lgkmcnt(0)" ::: "memory"); SBAR();
#define PK(L, H) (bf16x8){L[0], L[1], L[2], L[3], H[0], H[1], H[2], H[3]}
  od = __builtin_amdgcn_mfma_f32_32x32x16_bf16(pa0, PK(l0, h0), od, 0, 0, 0);
  od = __builtin_amdgcn_mfma_f32_32x32x16_bf16(pa1, PK(l1, h1), od, 0, 0, 0);
  od = __builtin_amdgcn_mfma_f32_32x32x16_bf16(pa2, PK(l2, h2), od, 0, 0, 0);
  od = __builtin_amdgcn_mfma_f32_32x32x16_bf16(pa3, PK(l3, h3), od, 0, 0, 0);
#undef PK
}
__device__ __forceinline__ void pv_d0(f32x16* o, int vb, bf16x8 pa0, bf16x8 pa1, bf16x8 pa2, bf16x8 pa3) {
  pv_one<0>(o[0], vb, pa0, pa1, pa2, pa3); pv_one<1>(o[1], vb, pa0, pa1, pa2, pa3); pv_one<2>(o[2], vb, pa0, pa1, pa2, pa3); pv_one<3>(o[3], vb, pa0, pa1, pa2, pa3);
}
__device__ __forceinline__ void na_mask(f32x16& p0, f32x16& p1, const float* bias  , int krow, int rq, int rs, int cq, int cs, int hi) {
  const bool rowok = (krow >= rs) && (krow <= rs + 7);
  int drow = krow - rq + 7; drow = drow < 0 ? 0 : (drow > 14 ? 14 : drow);
  const float* bt = bias + 64 + drow * 31 + (15 - cq + 4 * hi);
  const int kb = 4 * hi - cs;
#pragma unroll
  for (int r = 0; r < 16; ++r) { const int cr = (r & 3) + 8 * (r >> 2);
    const bool ok0 = rowok && (unsigned)(kb + cr) < 16u, ok1 = rowok && (unsigned)(kb + cr + 32) < 16u;
    const float b0 = bt[cr], b1 = bt[cr + 32];
    p0[r] = ok0 ? fmaf(p0[r], NA_SCALE, b0) : -INFINITY;
    p1[r] = ok1 ? fmaf(p1[r], NA_SCALE, b1) : -INFINITY; }
}

template <int MODE>
__device__ __forceinline__ void attn_unit(const bf16* __restrict__ Qb, int LDQ, const bf16* __restrict__ Kn, const bf16* __restrict__ Kr, const bf16* __restrict__ Vh, int LDK,
                                          bf16* __restrict__ Ob, int LDO, int kt0, int NT, char* lds, int r0, const float* __restrict__ rpb) {
  constexpr int ND0 = Cfg<MODE>::ND0, KP = Cfg<MODE>::KPITCH, SHM_K = Cfg<MODE>::SHM_K;
  const int tid = threadIdx.x, wid = tid >> 6, lane = tid & 63, r32 = lane & 31, hi = lane >> 5;
  char* V_lds = lds + OFF_V; char* K_lds = lds + OFF_K;
  float* ws = (float*)(lds + OFF_WS) + wid * 64; float* li_l = ws; float* al_l = ws + 32;
  float* bias_l = (float*)(lds + OFF_BIAS);
  constexpr int NQR = MODE == 0 ? ND0 - ATT_QLDS : ND0;
  float m_reg = -1e30f, l_reg = 0; f32x16 o[4] = {}; bf16x8 qr[NQR > 0 ? NQR : 1];
  const bf16* Qw = Qb + (long)(wid * QBLK + r32) * LDQ + hi * 8;
  char* ql = lds + OFF_QL + wid * (ATT_QLDS * 1024) + lane * 16;
#pragma unroll
  for (int d0 = 0; d0 < ND0; ++d0) { if (d0 < NQR) qr[d0 < NQR ? d0 : 0] = ld8(Qw + d0 * 16); else *reinterpret_cast<bf16x8*>(ql + (d0 - NQR) * 1024) = ld8(Qw + d0 * 16); }
  int rq = 0, rs = 0, cq = 0, cs = 0;
  if (MODE == 1) { rq = r0 + (wid >> 1); rs = rq - 4; rs = rs < 0 ? 0 : (rs > 120 ? 120 : rs); cq = (wid & 1) * 32 + r32; cs = cq - 8; cs = cs < 0 ? 0 : (cs > 48 ? 48 : cs);
    for (int i = tid; i < 15 * 31; i += 512) bias_l[64 + i] = rpb[i]; }
  const int sr = tid >> 4, sc = (tid & 15) * 8, vst0 = v_st(sr, sc), vst1 = v_st(32 + sr, sc);
  const int rr = tid >> 3, rc = (tid & 7) * 8;
  const int vb0 = (int)(uintptr_t)V_lds + v_rd_base(lane);
  const long k0g = (long)kt0 * KVBLK;
#ifndef ATT_SD
#define ATT_SD 1
#endif
#ifndef ATT_SIMPLE0
#define ATT_SIMPLE0 1
#endif
  struct { bf16x8 vs0, vs1, ks0, ks1, kr0; } sr_[ATT_SD];
#define SLOAD(i, kk) do { const long _k = k0g + (kk); sr_[i].vs0 = ld8(&Vh[(_k + sr) * LDK + sc]); sr_[i].vs1 = ld8(&Vh[(_k + 32 + sr) * LDK + sc]); \
    sr_[i].ks0 = ld8(&Kn[(_k + sr) * LDK + sc]); sr_[i].ks1 = ld8(&Kn[(_k + 32 + sr) * LDK + sc]); \
    if (MODE == 0) sr_[i].kr0 = ld8(&Kr[(_k + rr) * 64 + rc]); } while (0)
#define SWRITE(b, i) do { *(bf16x8*)(V_lds + (b) * SHM_V + vst0) = sr_[i].vs0;          \
    *(bf16x8*)(V_lds + (b) * SHM_V + vst1) = sr_[i].vs1; const int kc = sc * 2;               \
    *(bf16x8*)(K_lds + (b) * SHM_K + sr * KP + (kc ^ ((sr & 7) << 4))) = sr_[i].ks0;                       \
    *(bf16x8*)(K_lds + (b) * SHM_K + (32 + sr) * KP + (kc ^ ((sr & 7) << 4))) = sr_[i].ks1;            \
    if (MODE == 0) *(bf16x8*)(K_lds + (b) * SHM_K + rr * KP + ((256 + rc * 2) ^ ((rr & 7) << 4))) = sr_[i].kr0; } while (0)
#define SWAIT() do { if (ATT_SD == 1) asm volatile("s_waitcnt vmcnt(0)" ::: "memory"); else if (MODE == 0) asm volatile("s_waitcnt vmcnt(5)" ::: "memory"); else asm volatile("s_waitcnt vmcnt(4)" ::: "memory"); } while (0)
#define RESC(a) do { if (__any((a) < 1.f)) { if (hi == 0) al_l[r32] = (a); asm volatile("s_waitcnt lgkmcnt(0)" ::: "memory"); \
    _Pragma("unroll") for (int d = 0; d < 4; ++d) _Pragma("unroll") for (int r = 0; r < 16; ++r) o[d][r] *= al_l[crow(r, hi)]; } } while (0)
#define MASK(P0, P1, j) do { if (MODE == 1) na_mask(P0, P1, bias_l, kt0 + (j), rq, rs, cq, cs, hi); } while (0)
  bf16x8 pa0, pa1, pa2, pa3;
  if constexpr (MODE == 0 && ATT_SIMPLE0) {
    f32x16 pA0, pA1; float mnA, alA;
    SLOAD(0, 0); asm volatile("s_waitcnt vmcnt(0)" ::: "memory"); SWRITE(0, 0); __syncthreads();
    for (int j = 0; j < NT; ++j) {
      const int b = j & 1;
      if (j + 1 < NT) SLOAD(0, (j + 1) * KVBLK);
      SBAR(); qkt<MODE>(pA0, pA1, K_lds + b * SHM_K, qr, ql, r32, hi); MASK(pA0, pA1, j);
      partialSM<MODE>(pA0, pA1, m_reg, mnA, alA); RESC(alA);
      finishSM(pA0, pA1, alA, l_reg, pa0, pa1, pa2, pa3); SBAR();
      pv_d0(o, vb0 + b * SHM_V, pa0, pa1, pa2, pa3); SBAR();
      if (j + 1 < NT) SWRITE(b ^ 1, 0);
      __syncthreads();
    }
  } else {
  f32x16 pA0, pA1, pB0, pB1; float mnA, mnB, alA, alB; bf16x8 pa0, pa1, pa2, pa3;
  constexpr int SE = 0, SO = ATT_SD - 1;
  SLOAD(SE, 0); asm volatile("s_waitcnt vmcnt(0)" ::: "memory"); SWRITE(0, SE); __syncthreads();
  qkt<MODE>(pA0, pA1, K_lds, qr, ql, r32, hi); MASK(pA0, pA1, 0); partialSM<MODE>(pA0, pA1, m_reg, mnA, alA);
  SLOAD(SO, KVBLK); if (ATT_SD == 2) { if (2 < NT) SLOAD(SE, 2 * KVBLK); }
  SWAIT(); SWRITE(1, SO); __syncthreads();
  for (int j = 1; j + 1 < NT; j += 2) {
    SBAR(); qkt<MODE>(pB0, pB1, K_lds + SHM_K, qr, ql, r32, hi); MASK(pB0, pB1, j);
    finishSM(pA0, pA1, alA, l_reg, pa0, pa1, pa2, pa3); SBAR();
    SLOAD(SO, (j + ATT_SD) * KVBLK); SBAR();
    pv_d0(o, vb0, pa0, pa1, pa2, pa3); partialSM<MODE>(pB0, pB1, m_reg, mnB, alB);
    __syncthreads(); SWAIT(); SWRITE(0, SE);
    RESC(alB); __syncthreads();
    SBAR(); qkt<MODE>(pA0, pA1, K_lds, qr, ql, r32, hi); MASK(pA0, pA1, j + 1);
    finishSM(pB0, pB1, alB, l_reg, pa0, pa1, pa2, pa3); SBAR();
    if (ATT_SD == 1 || j + 3 < NT) SLOAD(SE, (j + 1 + ATT_SD) * KVBLK); SBAR();
    pv_d0(o, vb0 + SHM_V, pa0, pa1, pa2, pa3); partialSM<MODE>(pA0, pA1, m_reg, mnA, alA);
    __syncthreads(); SWAIT(); SWRITE(1, SO);
    RESC(alA); __syncthreads();
  }
  SBAR(); qkt<MODE>(pB0, pB1, K_lds + SHM_K, qr, ql, r32, hi); MASK(pB0, pB1, NT - 1);
  finishSM(pA0, pA1, alA, l_reg, pa0, pa1, pa2, pa3); SBAR();
  pv_d0(o, vb0, pa0, pa1, pa2, pa3); partialSM<MODE>(pB0, pB1, m_reg, mnB, alB);
  __syncthreads(); RESC(alB);
  finishSM(pB0, pB1, alB, l_reg, pa0, pa1, pa2, pa3); SBAR();
  pv_d0(o, vb0 + SHM_V, pa0, pa1, pa2, pa3);
  }
  if (hi == 0) li_l[r32] = l_reg; asm volatile("s_waitcnt lgkmcnt(0)" ::: "memory");
  float rli[16];
#pragma unroll
  for (int r = 0; r < 16; ++r) rli[r] = __builtin_amdgcn_rcpf(li_l[crow(r, hi)]);
  bf16* Ow = Ob + (long)(wid * QBLK) * LDO;
#pragma unroll
  for (int r = 0; r < 16; ++r) { const int orow = crow(r, hi);
#pragma unroll
    for (int d0 = 0; d0 < 4; ++d0) { const float v = o[d0][r] * rli[r]; Ow[(long)orow * LDO + d0 * 32 + r32] = (bf16)(cvtpk(v, v) & 0xffffu); } }
  __syncthreads();
#undef SLOAD
#undef SWRITE
#undef SWAIT
#undef RESC
#undef MASK
}
#undef SBAR
}

constexpr int NWAVES = 8;
constexpr int S = 8192, DM = 2048, INC = 3904, ZLD = 4096, DFF = 8192;
constexpr size_t MiB = 1u << 20;
constexpr size_t WS_CS = 0;
constexpr size_t WS_SSQ1 = 2 * MiB;
constexpr size_t WS_SSQ2 = WS_SSQ1 + 512 * 1024;
constexpr size_t WS_SSQ3 = WS_SSQ2 + 512 * 1024;
constexpr size_t WS_WIN = 4 * MiB;
constexpr size_t WS_WUQ = 20 * MiB;
constexpr size_t WS_WUKV = 22 * MiB;
constexpr size_t WS_WOUT = 23 * MiB;
constexpr size_t WS_W1 = 31 * MiB;
constexpr size_t WS_W2 = 63 * MiB;
constexpr size_t WS_Z = 96 * MiB;
constexpr size_t WS_H = 160 * MiB;
constexpr size_t WS_Q = 160 * MiB;
constexpr size_t WS_KR = 184 * MiB;
constexpr size_t WS_KV = 192 * MiB;
constexpr size_t WS_MIX = 224 * MiB;
constexpr size_t WS_X1B = 96 * MiB;
constexpr size_t WS_U = 128 * MiB;
constexpr size_t WS_END = 256 * MiB;
constexpr int LDS_BYTES = 147456;
static_assert(att::ATTN_LDS_BYTES <= LDS_BYTES, "attention LDS");

#define GAS __attribute__((address_space(1)))
#define LAS __attribute__((address_space(3)))
typedef unsigned short bf16;
typedef unsigned v4u __attribute__((ext_vector_type(4)));
typedef float f32x4 __attribute__((ext_vector_type(4)));
typedef short bf16x8 __attribute__((ext_vector_type(8)));
#define LDS_WAIT() asm volatile("s_waitcnt lgkmcnt(0)" ::: "memory")
__device__ __forceinline__ unsigned f2bf(float f) { unsigned u = __builtin_bit_cast(unsigned, f); return (u + 0x7fffu + ((u >> 16) & 1u)) >> 16; }
__device__ __forceinline__ unsigned pk2(float lo, float hi) { return f2bf(lo) | (f2bf(hi) << 16); }
__device__ __forceinline__ float bf2f(unsigned short b) { return __builtin_bit_cast(float, (unsigned)b << 16); }
__device__ __forceinline__ float wave_sum(float v) {
#pragma unroll
    for (int o = 1; o < 64; o <<= 1) v += __shfl_xor(v, o);
    return v;
}
__device__ const float ROPE_INV[32] = {1.000000000e+00f, 7.498942614e-01f, 5.623413324e-01f, 4.216965139e-01f, 3.162277639e-01f, 2.371373773e-01f, 1.778279394e-01f, 1.333521307e-01f, 1.000000015e-01f, 7.498941571e-02f, 5.623413250e-02f, 4.216965288e-02f, 3.162277490e-02f, 2.371373773e-02f, 1.778279431e-02f, 1.333521493e-02f, 9.999999776e-03f, 7.498941850e-03f, 5.623413250e-03f, 4.216964822e-03f, 3.162277630e-03f, 2.371373586e-03f, 1.778279431e-03f, 1.333521446e-03f, 1.000000047e-03f, 7.498942432e-04f, 5.623413017e-04f, 4.216965172e-04f, 3.162277571e-04f, 2.371373703e-04f, 1.778279402e-04f, 1.333521504e-04f};
__device__ __forceinline__ void rope_cs(int pos, int i, float& c, float& s) {
    const float ang = (float)pos * ROPE_INV[i];
    const double t = (double)ang * 0.15915494309189535; const float fr = (float)(t - rint(t));
    s = __builtin_amdgcn_sinf(fr); c = __builtin_amdgcn_cosf(fr);
}

__device__ __forceinline__ int uq_perm(int n) { const int h = n / 192, d = n - h * 192; if (d < 128) return h * 128 + d; const int i = d - 128; return 1024 + h * 64 + ((i & 31) << 1) + (i >> 5); }
template <bool PERMQ>
__device__ __forceinline__ void p0_transpose_item(const float* __restrict__ W, const float* __restrict__ g, int K, int N, bf16* __restrict__ WT, LAS float* scr, int item, int lane) {
    const int nblk = N / 32, kb = item / nblk, nb = item % nblk, k0 = 64 * kb, n0 = 32 * nb;
#pragma unroll 8
    for (int i = 0; i < 32; ++i) { const int kk = 2 * i + (lane >> 5); float w = W[(size_t)(k0 + kk) * N + n0 + (lane & 31)]; if (g) w *= g[k0 + kk]; scr[kk * 33 + (lane & 31)] = w; }
    LDS_WAIT(); asm volatile("" ::: "memory");
    const int c = lane & 7;
#pragma unroll
    for (int j = 0; j < 4; ++j) { const int n = (lane >> 3) + 8 * j; const LAS float* s = scr + (8 * c) * 33 + n;
        v4u o; o.x = pk2(s[0 * 33], s[1 * 33]); o.y = pk2(s[2 * 33], s[3 * 33]); o.z = pk2(s[4 * 33], s[5 * 33]); o.w = pk2(s[6 * 33], s[7 * 33]);
        const int dn = PERMQ ? uq_perm(n0 + n) : (n0 + n);
        *(v4u*)(WT + (size_t)dn * K + k0 + 8 * c) = o; }
    LDS_WAIT(); asm volatile("" ::: "memory");
}
__device__ __forceinline__ void rms_row_to_bf16(const float* __restrict__ xrow, const float* __restrict__ g, bf16* __restrict__ orow, int lane) {
    const f32x4* xr = (const f32x4*)xrow + lane; const f32x4* gr = (const f32x4*)g + lane;
    f32x4 v[8]; float s = 0.f;
#pragma unroll
    for (int j = 0; j < 8; ++j) { v[j] = xr[64 * j]; s += pg8::dot4(v[j]); }
    const float rstd = 1.0f / sqrtf(wave_sum(s) * (1.f / 2048.f) + pg8::NORM_EPS);
    unsigned long long* o8 = (unsigned long long*)orow + lane;
#pragma unroll
    for (int j = 0; j < 8; ++j) { const f32x4 gg = gr[64 * j]; o8[64 * j] = (unsigned long long)pk2(v[j][0] * rstd * gg[0], v[j][1] * rstd * gg[1]) | ((unsigned long long)pk2(v[j][2] * rstd * gg[2], v[j][3] * rstd * gg[3]) << 32); }
}

struct Args { const float* in[15]; float* out; unsigned char* ws; int ph_lo, ph_hi; };
constexpr int N_PHASES = 9;

__global__ void __launch_bounds__(NWAVES * 64, 2) mk_fwd(Args args) {
    extern __shared__ __attribute__((aligned(16))) unsigned char lds[];
    cg::grid_group grid = cg::this_grid();
    const int tid = threadIdx.x, lane = tid & 63, wave = __builtin_amdgcn_readfirstlane(tid >> 6);
    const int G = gridDim.x, bx = blockIdx.x;
    unsigned char* ws = args.ws;
    const float* x = args.in[0]; const float* attn_g = args.in[1]; const float* w_in = args.in[2]; const float* qn_g = args.in[3]; const float* w_uq = args.in[4];
    const float* kvn_g = args.in[5]; const float* w_ukv = args.in[6]; const float* rpb = args.in[7]; const float* mla_g = args.in[8]; const float* na_g = args.in[9];
    const float* w_out = args.in[10]; const float* mlp_g = args.in[11]; const float* w_ff1 = args.in[12]; const float* w_ff2 = args.in[13]; const float* fin_g = args.in[14];
    float* out = args.out;
    float* CS = (float*)(ws + WS_CS); float* SSQ1 = (float*)(ws + WS_SSQ1); float* SSQ2 = (float*)(ws + WS_SSQ2); float* SSQ3 = (float*)(ws + WS_SSQ3);
    bf16* WIN = (bf16*)(ws + WS_WIN); bf16* WUQ = (bf16*)(ws + WS_WUQ); bf16* WUKV = (bf16*)(ws + WS_WUKV); bf16* WOUT = (bf16*)(ws + WS_WOUT); bf16* W1 = (bf16*)(ws + WS_W1); bf16* W2 = (bf16*)(ws + WS_W2);
    bf16* Z = (bf16*)(ws + WS_Z); bf16* H = (bf16*)(ws + WS_H); bf16* Q = (bf16*)(ws + WS_Q); bf16* KR = (bf16*)(ws + WS_KR); bf16* KV = (bf16*)(ws + WS_KV);
    bf16* MIX = (bf16*)(ws + WS_MIX); bf16* X1B = (bf16*)(ws + WS_X1B); bf16* U = (bf16*)(ws + WS_U);
    const int lo = args.ph_lo, hi = args.ph_hi;
#ifndef PH_MASK
#define PH_MASK 0x1ff
#endif
#define IN(k) ((((PH_MASK) >> (k)) & 1) && lo <= (k) && (k) < hi)
#define SEAM(k) do { if (IN(k) && IN((k) + 1)) grid.sync(); } while (0)
    const int gw = bx * NWAVES + wave, NGW = G * NWAVES;
    PG8_LAS unsigned char* ldsp = (PG8_LAS unsigned char*)lds;

    if (IN(0)) {
        LAS float* scr = (LAS float*)(ldsp + wave * 16384);
        constexpr int I_IN = (DM / 64) * (INC / 32), I_UQ = (512 / 64) * (1536 / 32), I_UKV = (256 / 64) * (2048 / 32), I_OUT = (DM / 64) * (DM / 32), I_1 = (DM / 64) * (DFF / 32), I_2 = (DFF / 64) * (DM / 32);
        constexpr int NITEMS = I_IN + I_UQ + I_UKV + I_OUT + I_1 + I_2;
        for (int it = gw; it < NITEMS; it += NGW) {
            int r = it;
            if (r < I_IN) { p0_transpose_item<false>(w_in, nullptr, DM, INC, WIN, scr, r, lane); continue; } r -= I_IN;
            if (r < I_UQ) { p0_transpose_item<true>(w_uq, qn_g, 512, 1536, WUQ, scr, r, lane); continue; } r -= I_UQ;
            if (r < I_UKV) { p0_transpose_item<false>(w_ukv, kvn_g, 256, 2048, WUKV, scr, r, lane); continue; } r -= I_UKV;
            if (r < I_OUT) { p0_transpose_item<false>(w_out, nullptr, DM, DM, WOUT, scr, r, lane); continue; } r -= I_OUT;
            if (r < I_1) { p0_transpose_item<false>(w_ff1, mlp_g, DM, DFF, W1, scr, r, lane); continue; } r -= I_1;
            p0_transpose_item<false>(w_ff2, nullptr, DFF, DM, W2, scr, r, lane);
        }
        for (int i = bx * 512 + tid; i < 192 * 2048 / 8; i += G * 512) ((v4u*)(WIN + (size_t)INC * DM))[i] = (v4u){0u, 0u, 0u, 0u};
        for (int m = gw; m < S; m += NGW) rms_row_to_bf16(x + (size_t)m * DM, attn_g, H + (size_t)m * DM, lane);
        for (int e = bx * 512 + tid; e < S * 32; e += G * 512) { float c, s; rope_cs(e >> 5, e & 31, c, s); CS[2 * e] = c; CS[2 * e + 1] = s; }
    }
    SEAM(0);
    if (IN(1)) {
        pg8::Gemm g{H, WIN, S, ZLD, DM, DM, DM}; pg8::StaticOrder So; So.init(S, ZLD, G, bx);
        pg8::EpiZ E{Z, SSQ1};
        pg8::gemm_phase<pg8::EpiZ, pg8::StaticOrder, true, true>(ldsp, g, So, E);
    }
    SEAM(1);
    if (IN(2)) {
        { pg8::Gemm g{Z, WUQ, S, 1536, 512, ZLD, 512}; pg8::StaticOrder So; So.init(S, 1536, G, bx);
          pg8::EpiQ E{Q, SSQ1, CS};
          pg8::gemm_phase<pg8::EpiQ, pg8::StaticOrder, true, true>(ldsp, g, So, E); }
        { pg8::Gemm g{Z + 512, WUKV, S, 2048, 256, ZLD, 256}; pg8::StaticOrder So; So.init(S, 2048, G, bx);
          pg8::EpiKV E{KV, SSQ1};
          pg8::gemm_phase<pg8::EpiKV, pg8::StaticOrder, true, true>(ldsp, g, So, E); }
        for (int e = bx * 512 + tid; e < S * 32; e += G * 512) { const int pos = e >> 5, i = e & 31;
            const float x1 = bf2f(Z[(size_t)pos * ZLD + 768 + i]), x2 = bf2f(Z[(size_t)pos * ZLD + 800 + i]); const float c = CS[2 * e], s = CS[2 * e + 1];
            ((unsigned*)KR)[e] = pk2(x1 * c - x2 * s, x1 * s + x2 * c); }
    }
    SEAM(2);
    if (IN(3)) {
#ifndef ATT_MASK
#define ATT_MASK 3
#endif
        if (ATT_MASK & 1) for (int u = bx; u < 256; u += G) { const int h = u & 7, qb = u >> 3;
            att::attn_unit<0>(Q + (size_t)qb * 256 * 1536 + h * 192, 1536, KV + h * 256, KR, KV + h * 256 + 128, 2048, MIX + (size_t)qb * 256 * 2048 + h * 128, 2048, 0, S / 64, (char*)lds, 0, nullptr); }
        if (ATT_MASK & 2) for (int u = bx; u < 256; u += G) { const int h = u & 7, qb = u >> 3, r0 = 4 * qb;
            int t0 = r0 - 4; t0 = t0 < 0 ? 0 : (t0 > 120 ? 120 : t0); int t1 = r0 + 3 - 4; t1 = (t1 < 0 ? 0 : (t1 > 120 ? 120 : t1)) + 7; int nt = t1 - t0 + 1; if (nt & 1) ++nt;
            att::attn_unit<1>(Z + (size_t)qb * 256 * ZLD + 832 + h * 128, ZLD, Z + 1856 + h * 128, nullptr, Z + 2880 + h * 128, ZLD, MIX + (size_t)qb * 256 * 2048 + 1024 + h * 128, 2048, t0, nt, (char*)lds, r0, rpb + h * 465); }
    }
    SEAM(3);
    if (IN(4)) {
        for (int m = gw; m < S; m += NGW) {
#pragma unroll
            for (int half = 0; half < 2; ++half) { bf16* rowp = MIX + (size_t)m * 2048 + half * 1024 + lane * 16; const float* gp = (half ? na_g : mla_g) + lane * 16;
                const bf16x8 a = *(const bf16x8*)rowp, b = *(const bf16x8*)(rowp + 8); float v[16]; float s = 0.f;
#pragma unroll
                for (int j = 0; j < 8; ++j) { v[j] = bf2f((unsigned short)a[j]); v[8 + j] = bf2f((unsigned short)b[j]); }
#pragma unroll
                for (int j = 0; j < 16; ++j) s += v[j] * v[j];
                const float rstd = 1.0f / sqrtf(wave_sum(s) * (1.f / 1024.f) + pg8::NORM_EPS);
                v4u o0, o1; const f32x4 g0 = *(const f32x4*)gp, g1 = *(const f32x4*)(gp + 4), g2 = *(const f32x4*)(gp + 8), g3 = *(const f32x4*)(gp + 12);
                o0.x = pk2(v[0] * rstd * g0[0], v[1] * rstd * g0[1]); o0.y = pk2(v[2] * rstd * g0[2], v[3] * rstd * g0[3]); o0.z = pk2(v[4] * rstd * g1[0], v[5] * rstd * g1[1]); o0.w = pk2(v[6] * rstd * g1[2], v[7] * rstd * g1[3]);
                o1.x = pk2(v[8] * rstd * g2[0], v[9] * rstd * g2[1]); o1.y = pk2(v[10] * rstd * g2[2], v[11] * rstd * g2[3]); o1.z = pk2(v[12] * rstd * g3[0], v[13] * rstd * g3[1]); o1.w = pk2(v[14] * rstd * g3[2], v[15] * rstd * g3[3]);
                *(v4u*)rowp = o0; *(v4u*)(rowp + 8) = o1; }
        }
    }
    SEAM(4);
    if (IN(5)) {
        pg8::Gemm g{MIX, WOUT, S, DM, DM, DM, DM}; pg8::StaticOrder So; So.init(S, DM, G, bx);
        pg8::EpiRes<true> E{x, out, X1B, SSQ2};
        for (int i = 0; ; ++i) { pg8::Unit uu; if (!So.next(i, uu)) break; pg8::OneUnit O1{uu}; pg8::gemm_phase<pg8::EpiRes<true>, pg8::OneUnit, false, true>(ldsp, g, O1, E); }
    }
    SEAM(5);
    if (IN(6)) {
        pg8::Gemm g{X1B, W1, S, DFF, DM, DM, DM}; pg8::StaticOrder So; So.init(S, DFF, G, bx);
        pg8::EpiFF1 E{U, SSQ2};
        pg8::gemm_phase<pg8::EpiFF1, pg8::StaticOrder, true, true>(ldsp, g, So, E);
    }
    SEAM(6);
    if (IN(7)) {
        pg8::Gemm g{U, W2, S, DM, DFF, DFF, DFF}; pg8::StaticOrder So; So.init(S, DM, G, bx);
        pg8::EpiRes<false> E{out, out, nullptr, SSQ3};
        for (int i = 0; ; ++i) { pg8::Unit uu; if (!So.next(i, uu)) break; pg8::OneUnit O1{uu}; pg8::gemm_phase<pg8::EpiRes<false>, pg8::OneUnit, false, true>(ldsp, g, O1, E); }
    }
    SEAM(7);
    if (IN(8)) {
        for (int m = gw; m < S; m += NGW) {
            const f32x4 sa = *(const f32x4*)(SSQ3 + (size_t)m * 8), sb = *(const f32x4*)(SSQ3 + (size_t)m * 8 + 4);
            const float rstd = 1.0f / sqrtf(((sa[0] + sa[1]) + (sa[2] + sa[3]) + (sb[0] + sb[1]) + (sb[2] + sb[3])) * (1.0f / 2048.0f) + pg8::NORM_EPS);
            f32x4* xr = (f32x4*)(out + (size_t)m * DM) + lane; const f32x4* gr = (const f32x4*)fin_g + lane;
#pragma unroll
            for (int j = 0; j < 8; ++j) { const f32x4 v = xr[64 * j], gg = gr[64 * j]; xr[64 * j] = v * rstd * gg; }
        }
    }
#undef IN
#undef SEAM
}

extern "C" void kernel_launch(void* const* d_in, const int* in_sizes, int n_in, void* d_out, int out_size, void* d_ws, size_t ws_size, hipStream_t stream) {
    static int grid = 0;
    if (grid == 0) {
        if (n_in != 15 || in_sizes[0] != S * DM || out_size != S * DM || ws_size < WS_END) { fprintf(stderr, "kernel_launch: unexpected shapes (n_in %d, in0 %d, out %d, ws %zu)\n", n_in, n_in > 0 ? in_sizes[0] : -1, out_size, ws_size); grid = -1; return; }
        int dev = 0, cus = 0, per_cu = 0;
        if (hipGetDevice(&dev) != hipSuccess || hipDeviceGetAttribute(&cus, hipDeviceAttributeMultiprocessorCount, dev) != hipSuccess) { grid = -1; return; }
        if (hipFuncSetAttribute((const void*)mk_fwd, hipFuncAttributeMaxDynamicSharedMemorySize, LDS_BYTES) != hipSuccess) { fprintf(stderr, "kernel_launch: hipFuncSetAttribute failed\n"); grid = -1; return; }
        if (hipOccupancyMaxActiveBlocksPerMultiprocessor(&per_cu, (const void*)mk_fwd, NWAVES * 64, LDS_BYTES) != hipSuccess || per_cu < 1) { fprintf(stderr, "kernel_launch: occupancy query failed (%d)\n", per_cu); (void)hipGetLastError(); per_cu = 1; }
        grid = cus * per_cu;
    }
    if (grid < 0) return;
    Args a{};
    for (int i = 0; i < 15; ++i) a.in[i] = (const float*)d_in[i];
    a.out = (float*)d_out; a.ws = (unsigned char*)d_ws;
#if MK_N_LAUNCHES == 1
    a.ph_lo = 0; a.ph_hi = N_PHASES;
    void* kargs[] = {&a};
    const hipError_t e = hipLaunchCooperativeKernel((const void*)mk_fwd, dim3(grid), dim3(NWAVES * 64), kargs, LDS_BYTES, stream);
    if (e != hipSuccess) fprintf(stderr, "kernel_launch: cooperative launch failed: %s (grid %d)\n", hipGetErrorString(e), grid);
#else
    for (int p = 0; p < N_PHASES; ++p) { a.ph_lo = p; a.ph_hi = p + 1; hipLaunchKernelGGL(mk_fwd, dim3(grid), dim3(NWAVES * 64), LDS_BYTES, stream, a); }
#endif
}
```

```cpp
#include <hip/hip_runtime.h>
#include <hip/hip_cooperative_groups.h>
#include <hip/hip_bf16.h>
#include <cstdio>
#include <cstdint>
#include <cmath>
namespace cg = cooperative_groups;

#ifndef MK_N_LAUNCHES
#define MK_N_LAUNCHES 1
#endif

namespace pg8 {
#define PG8_LAS __attribute__((address_space(3)))
typedef unsigned short bf16_t;
typedef short bf16x8 __attribute__((ext_vector_type(8)));
typedef float f32x4 __attribute__((ext_vector_type(4)));
typedef float f32x2 __attribute__((ext_vector_type(2)));
typedef unsigned u32x4 __attribute__((ext_vector_type(4)));
typedef unsigned u32x2 __attribute__((ext_vector_type(2)));
constexpr int BM = 256, BK = 64, HALF = 128, HTB = HALF * BK * 2  , STAGE_BYTES = 8 * HTB, NXCD = 8, WGM = 8;

__host__ __device__ __forceinline__ int lds_byte(int r, int c) { const int st = (r >> 4) * 2 + (c >> 5), rr = r & 15, cc = c & 31, ob = rr * 64 + cc * 2; return st * 1024 + (ob ^ (((ob >> 9) & 1) << 5)); }
__host__ __device__ __forceinline__ void stage_rc(int b, int& R, int& C) { const int st = b / 1024, sb = b % 1024, swz = sb ^ (((sb >> 9) & 1) << 5); R = (st >> 1) * 16 + swz / 64; C = (st & 1) * 32 + (swz % 64) / 2; }
__host__ __device__ __forceinline__ int perm32(int rho) { const int n = rho >> 4, i = rho & 15; return 8 * (i >> 2) + 4 * n + (i & 3); }

struct Unit { int pm, pn; };
struct Gemm { const bf16_t* A; const bf16_t* Bt; int M, N, K, lda, ldb; };

struct StaticOrder {
    int nM, nN, nwg, G, c;
    __host__ __device__ void init(int M, int N, int G_, int c_) { nM = M / BM; nN = N / BM; nwg = nM * nN; G = G_; c = c_; }
    __host__ __device__ bool next(int i, Unit& u) const {
        const long L = (long)i * G + c; if (L >= nwg) return false;
        int wgid = (int)L; { const int q = nwg / NXCD, r = nwg % NXCD, xcd = wgid % NXCD, off = wgid / NXCD; wgid = (xcd < r ? xcd * (q + 1) : r * (q + 1) + (xcd - r) * q) + off; }
        const int nig = WGM * nN, gid = wgid / nig, fm = gid * WGM, gsz = (nM - fm) < WGM ? (nM - fm) : WGM;
        u.pm = fm + ((wgid % nig) % gsz); u.pn = (wgid % nig) / gsz; return true;
    }
    __device__ __forceinline__ void a_ready(const Unit&) const {}
    __device__ __forceinline__ void done(const Unit&) const {}
};

struct OneUnit { Unit u;
    __device__ __forceinline__ bool next(int i, Unit& o) const { if (i != 0) return false; o = u; return true; }
    __device__ __forceinline__ void a_ready(const Unit&) const {}
    __device__ __forceinline__ void done(const Unit&) const {}
};

__device__ __forceinline__ unsigned cvt_pk_bf16(float lo, float hi) { unsigned r; asm volatile("v_cvt_pk_bf16_f32 %0, %1, %2" : "=v"(r) : "v"(lo), "v"(hi)); return r; }
constexpr float NORM_EPS = 1e-6f;

__device__ __forceinline__ u32x4 pack8(f32x4 v0, f32x4 v1) { u32x4 w; w.x = cvt_pk_bf16(v0[0], v0[1]); w.y = cvt_pk_bf16(v0[2], v0[3]); w.z = cvt_pk_bf16(v1[0], v1[1]); w.w = cvt_pk_bf16(v1[2], v1[3]); return w; }
__device__ __forceinline__ float dot4(f32x4 v) { return (v[0] * v[0] + v[1] * v[1]) + (v[2] * v[2] + v[3] * v[3]); }

struct EpiZ {
    static constexpr bool PERM = true, AFTER_DRAIN = false;
    bf16_t* Z; float* ssq;
    __device__ __forceinline__ void operator()(const f32x4 (&acc)[2][2][4][2], const Unit& u, int wr, int wc, int fr, int fq) const {
        const int row0 = u.pm * BM + wr * 64 + fr, col0 = u.pn * BM + wc * 32 + 8 * fq;
#pragma unroll
        for (int ai = 0; ai < 2; ++ai)
#pragma unroll
            for (int m = 0; m < 4; ++m) { const int row = row0 + ai * HALF + m * 16; bf16_t* rowp = Z + (size_t)row * 4096 + col0; float s = 0.f;
#pragma unroll
                for (int bj = 0; bj < 2; ++bj) { const f32x4 v0 = acc[ai][bj][m][0], v1 = acc[ai][bj][m][1]; s += dot4(v0) + dot4(v1); *(u32x4*)(rowp + bj * HALF) = pack8(v0, v1); }
                if (u.pn < 3) { s += __shfl_xor(s, 16); s += __shfl_xor(s, 32); if (fq == 0) ssq[(size_t)row * 12 + u.pn * 4 + wc] = s; } }
    }
};
struct EpiQ {
    static constexpr bool PERM = true, AFTER_DRAIN = false;
    bf16_t* Q; const float* ssq; const float* cs;
    __device__ __forceinline__ void operator()(const f32x4 (&acc)[2][2][4][2], const Unit& u, int wr, int wc, int fr, int fq) const {
        const int row0 = u.pm * BM + wr * 64 + fr, col0 = u.pn * BM + wc * 32 + 8 * fq;
#pragma unroll
        for (int ai = 0; ai < 2; ++ai)
#pragma unroll
            for (int m = 0; m < 4; ++m) { const int row = row0 + ai * HALF + m * 16;
                const f32x4 sa = *(const f32x4*)(ssq + (size_t)row * 12), sb = *(const f32x4*)(ssq + (size_t)row * 12 + 4);
                const float rstd = 1.0f / sqrtf(((sa[0] + sa[1]) + (sa[2] + sa[3]) + (sb[0] + sb[1]) + (sb[2] + sb[3])) * (1.0f / 512.0f) + NORM_EPS);
#pragma unroll
                for (int bj = 0; bj < 2; ++bj) { f32x4 v0 = acc[ai][bj][m][0] * rstd, v1 = acc[ai][bj][m][1] * rstd; const int colg = col0 + bj * HALF; bf16_t* dst;
                    if (u.pn >= 4) { const int cr = colg - 1024, head = cr >> 6, jj = cr & 63;
                        const f32x4 c0 = *(const f32x4*)(cs + (size_t)row * 64 + jj), c1 = *(const f32x4*)(cs + (size_t)row * 64 + jj + 4);
                        f32x4 w0, w1;
                        w0[0] = v0[0] * c0[0] - v0[1] * c0[1]; w0[1] = v0[0] * c0[1] + v0[1] * c0[0]; w0[2] = v0[2] * c0[2] - v0[3] * c0[3]; w0[3] = v0[2] * c0[3] + v0[3] * c0[2];
                        w1[0] = v1[0] * c1[0] - v1[1] * c1[1]; w1[1] = v1[0] * c1[1] + v1[1] * c1[0]; w1[2] = v1[2] * c1[2] - v1[3] * c1[3]; w1[3] = v1[2] * c1[3] + v1[3] * c1[2];
                        v0 = w0; v1 = w1; dst = Q + (size_t)row * 1536 + head * 192 + 128 + jj; }
                    else { const int head = colg >> 7, d = colg & 127; dst = Q + (size_t)row * 1536 + head * 192 + d; }
                    *(u32x4*)dst = pack8(v0, v1); } }
    }
};
struct EpiKV {
    static constexpr bool PERM = true, AFTER_DRAIN = false;
    bf16_t* KV; const float* ssq;
    __device__ __forceinline__ void operator()(const f32x4 (&acc)[2][2][4][2], const Unit& u, int wr, int wc, int fr, int fq) const {
        const int row0 = u.pm * BM + wr * 64 + fr, col0 = u.pn * BM + wc * 32 + 8 * fq;
#pragma unroll
        for (int ai = 0; ai < 2; ++ai)
#pragma unroll
            for (int m = 0; m < 4; ++m) { const int row = row0 + ai * HALF + m * 16;
                const f32x4 sa = *(const f32x4*)(ssq + (size_t)row * 12 + 8);
                const float rstd = 1.0f / sqrtf(((sa[0] + sa[1]) + (sa[2] + sa[3])) * (1.0f / 256.0f) + NORM_EPS);
                bf16_t* rowp = KV + (size_t)row * 2048 + col0;
#pragma unroll
                for (int bj = 0; bj < 2; ++bj) *(u32x4*)(rowp + bj * HALF) = pack8(acc[ai][bj][m][0] * rstd, acc[ai][bj][m][1] * rstd); }
    }
};
struct EpiFF1 {
    static constexpr bool PERM = true, AFTER_DRAIN = false;
    bf16_t* U; const float* ssq2;
    __device__ __forceinline__ void operator()(const f32x4 (&acc)[2][2][4][2], const Unit& u, int wr, int wc, int fr, int fq) const {
        const int row0 = u.pm * BM + wr * 64 + fr, col0 = u.pn * BM + wc * 32 + 8 * fq;
#pragma unroll
        for (int ai = 0; ai < 2; ++ai)
#pragma unroll
            for (int m = 0; m < 4; ++m) { const int row = row0 + ai * HALF + m * 16;
                const f32x4 sa = *(const f32x4*)(ssq2 + (size_t)row * 8), sb = *(const f32x4*)(ssq2 + (size_t)row * 8 + 4);
                const float rstd = 1.0f / sqrtf(((sa[0] + sa[1]) + (sa[2] + sa[3]) + (sb[0] + sb[1]) + (sb[2] + sb[3])) * (1.0f / 2048.0f) + NORM_EPS);
                bf16_t* rowp = U + (size_t)row * 8192 + col0;
#pragma unroll
                for (int bj = 0; bj < 2; ++bj) { f32x4 v0 = acc[ai][bj][m][0] * rstd, v1 = acc[ai][bj][m][1] * rstd;
#pragma unroll
                    for (int j = 0; j < 4; ++j) { const float a = fmaxf(v0[j], 0.f), b = fmaxf(v1[j], 0.f); v0[j] = a * a; v1[j] = b * b; }
                    *(u32x4*)(rowp + bj * HALF) = pack8(v0, v1); } }
    }
};
template <bool WRITE_B> struct EpiRes {
    static constexpr bool PERM = false, AFTER_DRAIN = true;
    const float* base; float* out; bf16_t* xb; float* ssq;
    __device__ __forceinline__ void fused(f32x4 (&acc)[2][2][4][2], const Unit& u, int wr, int wc, int fr, int fq, PG8_LAS unsigned char* lds, int wid, int lane) const {
        PG8_LAS float* P = (PG8_LAS float*)lds;
        const int col0 = u.pn * BM + wc * 32 + 4 * fq;
#pragma unroll
        for (int ai = 0; ai < 2; ++ai)
#pragma unroll
            for (int m = 0; m < 4; ++m) { const int r = ai * HALF + wr * 64 + m * 16 + fr; const size_t off = (size_t)(u.pm * BM + r) * 2048 + col0; float s = 0.f;
#pragma unroll
                for (int bj = 0; bj < 2; ++bj)
#pragma unroll
                    for (int n = 0; n < 2; ++n) { const f32x4 v = *(const f32x4*)(base + off + bj * HALF + n * 16) + acc[ai][bj][m][n]; s += dot4(v);
                        *(f32x4*)(out + off + bj * HALF + n * 16) = v;
                        if (WRITE_B) { u32x2 w; w.x = cvt_pk_bf16(v[0], v[1]); w.y = cvt_pk_bf16(v[2], v[3]); *(u32x2*)(xb + off + bj * HALF + n * 16) = w; } }
                s += __shfl_xor(s, 16); s += __shfl_xor(s, 32);
                if (fq == 0) P[r * 4 + wc] = s;
                if (m & 1) asm volatile("" ::: "memory"); }
        asm volatile("s_waitcnt lgkmcnt(0)" ::: "memory"); __builtin_amdgcn_s_barrier(); asm volatile("" ::: "memory");
        const int t = wid * 64 + lane;
        if (t < 256) ssq[(size_t)(u.pm * BM + t) * 8 + u.pn] = (P[t * 4 + 0] + P[t * 4 + 1]) + (P[t * 4 + 2] + P[t * 4 + 3]);
        asm volatile("s_waitcnt lgkmcnt(0)" ::: "memory"); __builtin_amdgcn_s_barrier(); asm volatile("" ::: "memory");
    }
};

template <class Epi, class Sched, bool ALIGN_EPI = false, bool SP2 = false>
__device__ __forceinline__ void gemm_phase(PG8_LAS unsigned char* lds, const Gemm g, const Sched& S, const Epi& E) {
    const int tid = threadIdx.x, wid = __builtin_amdgcn_readfirstlane(tid >> 6), lane = tid & 63, wr = wid >> 2, wc = wid & 3, fr = lane & 15, fq = lane >> 4;
    const int K = g.K, nt = K / BK;
    unsigned voffA[2], voffB[2];
#pragma unroll
    for (int i = 0; i < 2; ++i) { int R, C; stage_rc(tid * 16 + i * 8192, R, C); const int Rb = Epi::PERM ? ((R & ~31) + perm32(R & 31)) : R;
        voffA[i] = (unsigned)(R * g.lda + C) * 2u; voffB[i] = (unsigned)(Rb * g.ldb + C) * 2u; }
    const size_t kstep = (size_t)(BK * 2);
    const size_t hstepA = (size_t)HALF * g.lda * 2, hstepB = (size_t)HALF * g.ldb * 2;
    const size_t tstepA = 2 * hstepA, tstepB = 2 * hstepB;
    const unsigned ldsw = (unsigned)wid * 1024u;
    const int aoff = lds_byte(wr * 64 + fr, fq * 8), boff = lds_byte(wc * 32 + fr, fq * 8);
#define PG8_SA(b, h) (((b) * 2 + (h)) * HTB)
#define PG8_SB(b, h) ((4 + (b) * 2 + (h)) * HTB)
#define PG8_STAGE(bufoff, gbase, voff) do { _Pragma("unroll") for (int _i = 0; _i < 2; ++_i) \
        __builtin_amdgcn_global_load_lds((const unsigned*)((const char*)(gbase) + (voff)[_i]), (PG8_LAS unsigned*)(lds + (bufoff) + ldsw + _i * 8192), 16, 0, 0); } while (0)
#define PG8_LDA(dst, b, h) do { _Pragma("unroll") for (int m = 0; m < 4; ++m) _Pragma("unroll") for (int k = 0; k < 2; ++k) dst[m][k] = *(const PG8_LAS bf16x8*)(lds + PG8_SA(b, h) + aoff + m * 2048 + k * 1024); } while (0)
#define PG8_LDB(dst, b, h) do { _Pragma("unroll") for (int n = 0; n < 2; ++n) _Pragma("unroll") for (int k = 0; k < 2; ++k) dst[n][k] = *(const PG8_LAS bf16x8*)(lds + PG8_SB(b, h) + boff + n * 2048 + k * 1024); } while (0)
#define PG8_MMA(ai, bj, At, Bt) do { __builtin_amdgcn_s_setprio(1); _Pragma("unroll") for (int m = 0; m < 4; ++m) _Pragma("unroll") for (int n = 0; n < 2; ++n) _Pragma("unroll") for (int k = 0; k < 2; ++k) \
        acc[ai][bj][m][n] = __builtin_amdgcn_mfma_f32_16x16x32_bf16(Bt[n][k], At[m][k], acc[ai][bj][m][n], 0, 0, 0); __builtin_amdgcn_s_setprio(0); } while (0)
#define PG8_WAIT_V(n) asm volatile("s_waitcnt vmcnt(" #n ")" ::: "memory")
#define PG8_WAIT_L(n) asm volatile("s_waitcnt lgkmcnt(" #n ")" ::: "memory")
#define PG8_BAR __builtin_amdgcn_s_barrier()
#define PG8_SCHED __builtin_amdgcn_sched_barrier(0)
    Unit cur, nxt; int ui = 0;
    if (!S.next(0, cur)) return;
    f32x4 acc[2][2][4][2];
#pragma unroll
    for (int a = 0; a < 2; ++a)
#pragma unroll
        for (int b = 0; b < 2; ++b)
#pragma unroll
            for (int m = 0; m < 4; ++m)
#pragma unroll
                for (int n = 0; n < 2; ++n) acc[a][b][m][n] = (f32x4){0.f, 0.f, 0.f, 0.f};
    bf16x8 At[4][2], B0[2][2], B1[2][2];
    const char* cA = (const char*)g.A + (size_t)cur.pm * tstepA; const char* cB = (const char*)g.Bt + (size_t)cur.pn * tstepB;
    S.a_ready(cur);
    if constexpr (SP2) {
        PG8_STAGE(PG8_SB(0, 0), cB, voffB); PG8_STAGE(PG8_SB(0, 1), cB + hstepB, voffB); PG8_STAGE(PG8_SA(0, 0), cA, voffA); PG8_STAGE(PG8_SA(0, 1), cA + hstepA, voffA);
        if (wr == 1) PG8_BAR;
        PG8_WAIT_V(2); PG8_BAR;
        PG8_STAGE(PG8_SB(1, 0), cB + kstep, voffB); PG8_STAGE(PG8_SA(1, 0), cA + kstep, voffA); PG8_STAGE(PG8_SB(1, 1), cB + hstepB + kstep, voffB);
        PG8_WAIT_V(6); PG8_BAR;
    } else {
        PG8_STAGE(PG8_SB(0, 0), cB, voffB); PG8_STAGE(PG8_SA(0, 0), cA, voffA); PG8_STAGE(PG8_SB(0, 1), cB + hstepB, voffB); PG8_STAGE(PG8_SA(0, 1), cA + hstepA, voffA);
        if (wr == 1) PG8_BAR;
        PG8_WAIT_V(4); PG8_BAR;
        PG8_STAGE(PG8_SB(1, 0), cB + kstep, voffB); PG8_STAGE(PG8_SA(1, 0), cA + kstep, voffA); PG8_STAGE(PG8_SB(1, 1), cB + hstepB + kstep, voffB);
        PG8_WAIT_V(6); PG8_BAR;
    }
    for (;;) {
        const bool has_next = S.next(ui + 1, nxt);
        const char* nA = has_next ? (const char*)g.A + (size_t)nxt.pm * tstepA : cA; const char* nB = has_next ? (const char*)g.Bt + (size_t)nxt.pn * tstepB : cB;
        for (int t = 0; t < nt; t += 2) {
            const bool last = (t == nt - 2);
            const char* a1 = cA + (size_t)(t + 1) * kstep;
            const char* a2 = last ? nA : cA + (size_t)(t + 2) * kstep; const char* b2 = last ? nB : cB + (size_t)(t + 2) * kstep;
            const char* a3 = a2 + kstep; const char* b3 = b2 + kstep;
            if (last && has_next) S.a_ready(nxt);
            if constexpr (SP2) {
            PG8_LDB(B0, 0, 0); PG8_LDB(B1, 0, 1); PG8_SCHED; PG8_LDA(At, 0, 0); PG8_STAGE(PG8_SA(1, 1), a1 + hstepA, voffA);
            PG8_WAIT_V(8); PG8_WAIT_L(0); PG8_BAR; PG8_MMA(0, 0, At, B0); PG8_MMA(0, 1, At, B1); PG8_BAR; PG8_SCHED;
            PG8_LDA(At, 0, 1); PG8_STAGE(PG8_SB(0, 0), b2, voffB); PG8_STAGE(PG8_SB(0, 1), b2 + hstepB, voffB); PG8_STAGE(PG8_SA(0, 0), a2, voffA);
            PG8_WAIT_V(8); PG8_WAIT_L(0); PG8_BAR; PG8_MMA(1, 0, At, B0); PG8_MMA(1, 1, At, B1); PG8_BAR; PG8_SCHED;
            PG8_LDB(B0, 1, 0); PG8_LDB(B1, 1, 1); PG8_SCHED; PG8_LDA(At, 1, 0); PG8_STAGE(PG8_SA(0, 1), a2 + hstepA, voffA);
            PG8_WAIT_V(8); PG8_WAIT_L(0); PG8_BAR; PG8_MMA(0, 0, At, B0); PG8_MMA(0, 1, At, B1); PG8_BAR; PG8_SCHED;
            PG8_LDA(At, 1, 1); PG8_STAGE(PG8_SB(1, 0), b3, voffB); PG8_STAGE(PG8_SB(1, 1), b3 + hstepB, voffB); PG8_STAGE(PG8_SA(1, 0), a3, voffA);
            PG8_WAIT_V(8); PG8_WAIT_L(0); PG8_BAR; PG8_MMA(1, 0, At, B0); PG8_MMA(1, 1, At, B1); PG8_BAR; PG8_SCHED;
            } else {
            PG8_LDB(B0, 0, 0); PG8_SCHED; PG8_LDA(At, 0, 0); PG8_STAGE(PG8_SA(1, 1), a1 + hstepA, voffA);
            PG8_WAIT_L(8); PG8_BAR; PG8_WAIT_L(0); PG8_MMA(0, 0, At, B0); PG8_BAR; PG8_SCHED;
            PG8_LDB(B1, 0, 1); PG8_STAGE(PG8_SB(0, 0), b2, voffB);
            PG8_BAR; PG8_WAIT_L(0); PG8_MMA(0, 1, At, B1); PG8_BAR;
            PG8_LDA(At, 0, 1); PG8_STAGE(PG8_SA(0, 0), a2, voffA);
            PG8_BAR; PG8_WAIT_L(0); PG8_MMA(1, 0, At, B0); PG8_BAR; PG8_SCHED;
            PG8_STAGE(PG8_SB(0, 1), b2 + hstepB, voffB);
            PG8_WAIT_V(6); PG8_BAR; PG8_MMA(1, 1, At, B1); PG8_BAR;
            PG8_LDB(B0, 1, 0); PG8_SCHED; PG8_LDA(At, 1, 0); PG8_STAGE(PG8_SA(0, 1), a2 + hstepA, voffA);
            PG8_WAIT_L(8); PG8_BAR; PG8_WAIT_L(0); PG8_MMA(0, 0, At, B0); PG8_BAR; PG8_SCHED;
            PG8_LDB(B1, 1, 1); PG8_STAGE(PG8_SB(1, 0), b3, voffB);
            PG8_BAR; PG8_WAIT_L(0); PG8_MMA(0, 1, At, B1); PG8_BAR;
            PG8_LDA(At, 1, 1); PG8_STAGE(PG8_SA(1, 0), a3, voffA);
            PG8_BAR; PG8_WAIT_L(0); PG8_MMA(1, 0, At, B0); PG8_BAR; PG8_SCHED;
            PG8_STAGE(PG8_SB(1, 1), b3 + hstepB, voffB);
            PG8_WAIT_V(6); PG8_BAR; PG8_MMA(1, 1, At, B1); PG8_BAR;
            }
        }
        if constexpr (ALIGN_EPI) { if (wr == 0) PG8_BAR; }
        if constexpr (!Epi::AFTER_DRAIN) { E(acc, cur, wr, wc, fr, fq); S.done(cur); }
        if (!has_next) break;
#pragma unroll
        for (int a = 0; a < 2; ++a)
#pragma unroll
            for (int b = 0; b < 2; ++b)
#pragma unroll
                for (int m = 0; m < 4; ++m)
#pragma unroll
                    for (int n = 0; n < 2; ++n) acc[a][b][m][n] = (f32x4){0.f, 0.f, 0.f, 0.f};
        cur = nxt; cA = nA; cB = nB; ++ui;
        if constexpr (ALIGN_EPI) { if (wr == 1) PG8_BAR; }
    }
    PG8_WAIT_V(0);
    if constexpr (!ALIGN_EPI) { if (wr == 0) PG8_BAR; }
    PG8_BAR;
    if constexpr (Epi::AFTER_DRAIN) { E.fused(acc, cur, wr, wc, fr, fq, lds, wid, lane); S.done(cur); }
#undef PG8_SA
#undef PG8_SB
#undef PG8_STAGE
#undef PG8_LDA
#undef PG8_LDB
#undef PG8_MMA
#undef PG8_WAIT_V
#undef PG8_WAIT_L
#undef PG8_BAR
#undef PG8_SCHED
}
}
namespace att {
using bf16 = unsigned short;
using bf16x8 = __attribute__((ext_vector_type(8))) short;
using s16x4  = __attribute__((ext_vector_type(4))) short;
using f32x16 = __attribute__((ext_vector_type(16))) float;
using u32x4  = __attribute__((ext_vector_type(4))) unsigned;
constexpr int NW = 8, QBLK = 32, KVBLK = 64, DV = 128;
constexpr float THR = 8.f;
constexpr int SHM_V = KVBLK * DV * 2;
constexpr int SHM_KMAX = KVBLK * 192 * 2;
#ifndef ATT_QLDS
#define ATT_QLDS 0
#endif
constexpr int OFF_V = 0, OFF_K = 2 * SHM_V, OFF_WS = OFF_K + 2 * SHM_KMAX, OFF_BIAS = OFF_WS + NW * 64 * 4, OFF_QL = OFF_BIAS + 4096, ATTN_LDS_BYTES = OFF_QL + NW * ATT_QLDS * 1024;
#define SBAR() __builtin_amdgcn_sched_barrier(0)
__device__ __forceinline__ int crow(int r, int hi) { return (r & 3) + 8 * (r >> 2) + 4 * hi; }
__device__ __forceinline__ unsigned cvtpk(float lo, float hi) { unsigned r; asm volatile("v_cvt_pk_bf16_f32 %0, %1, %2" : "=v"(r) : "v"(lo), "v"(hi)); return r; }
__device__ __forceinline__ bf16x8 ld8(const bf16* p) { return *reinterpret_cast<const bf16x8*>(p); }

template <int MODE> struct Cfg {
    static constexpr int DQ = MODE == 0 ? 192 : 128, ND0 = DQ / 16, KPITCH = DQ * 2, SHM_K = KVBLK * KPITCH;
    static constexpr float SCALE = MODE == 0 ? 0.07216878364870322f : 1.0f;
};
constexpr float NA_SCALE = 0.08838834764831845f;

template <int MODE>
__device__ __forceinline__ void partialSM(f32x16& p0, f32x16& p1, float& m_reg, float& mn, float& alpha) {
  constexpr float SC = Cfg<MODE>::SCALE, C = SC * 1.4426950408889634f;
  float pmax = p0[0];
#pragma unroll
  for (int r = 1; r < 16; ++r) pmax = fmaxf(pmax, p0[r]);
#pragma unroll
  for (int r = 0; r < 16; ++r) pmax = fmaxf(pmax, p1[r]);
  { auto rr = __builtin_amdgcn_permlane32_swap(__float_as_uint(pmax), __float_as_uint(pmax), false, false);
    pmax = fmaxf(__uint_as_float(rr[0]), __uint_as_float(rr[1])); }
  if (__builtin_expect(__all(pmax - m_reg <= THR / SC), 1)) { mn = m_reg; alpha = 1.f; }
  else { mn = fmaxf(m_reg, pmax); alpha = __builtin_amdgcn_exp2f((m_reg - mn) * C); m_reg = mn; }
  float mnC = -mn * C;
#pragma unroll
  for (int r = 0; r < 16; ++r) p0[r] = fmaf(p0[r], C, mnC);
#pragma unroll
  for (int r = 0; r < 16; ++r) p1[r] = fmaf(p1[r], C, mnC);
#pragma unroll
  for (int r = 0; r < 16; ++r) p0[r] = __builtin_amdgcn_exp2f(p0[r]);
}
__device__ __forceinline__ void finishSM(f32x16& p0, f32x16& p1, float alpha, float& l_reg, bf16x8& pa0, bf16x8& pa1, bf16x8& pa2, bf16x8& pa3) {
#pragma unroll
  for (int r = 0; r < 16; ++r) p1[r] = __builtin_amdgcn_exp2f(p1[r]);
  float ps = 0;
#pragma unroll
  for (int r = 0; r < 16; ++r) ps += p0[r];
#pragma unroll
  for (int r = 0; r < 16; ++r) ps += p1[r];
  { auto rr = __builtin_amdgcn_permlane32_swap(__float_as_uint(ps), __float_as_uint(ps), false, false);
    ps = __uint_as_float(rr[0]) + __uint_as_float(rr[1]); }
  l_reg = l_reg * alpha + ps;
#define PK4(P, BASE, OUT) do { unsigned a0 = cvtpk(P[BASE + 0], P[BASE + 1]), a1 = cvtpk(P[BASE + 2], P[BASE + 3]);   \
    unsigned b0 = cvtpk(P[BASE + 4], P[BASE + 5]), b1 = cvtpk(P[BASE + 6], P[BASE + 7]);                              \
    auto r0 = __builtin_amdgcn_permlane32_swap(a0, b0, false, false); auto r1 = __builtin_amdgcn_permlane32_swap(a1, b1, false, false); \
    u32x4 w = {r0[0], r1[0], r0[1], r1[1]}; OUT = *reinterpret_cast<bf16x8*>(&w); } while (0)
  PK4(p0, 0, pa0); PK4(p0, 8, pa1); PK4(p1, 0, pa2); PK4(p1, 8, pa3);
#undef PK4
}
template <int MODE>
__device__ __forceinline__ void qkt(f32x16& p0, f32x16& p1, const char* Ks, const bf16x8* qr, const char* ql, int r32, int hi) {
  constexpr int NREG = MODE == 0 ? Cfg<MODE>::ND0 - ATT_QLDS : Cfg<MODE>::ND0;
  constexpr int KP = Cfg<MODE>::KPITCH;
  p0 = f32x16{}; p1 = f32x16{};
#pragma unroll
  for (int d0 = 0; d0 < Cfg<MODE>::ND0; ++d0) { const int cb = (d0 * 16 + hi * 8) * 2;
    bf16x8 b0 = *reinterpret_cast<const bf16x8*>(Ks + r32 * KP + (cb ^ ((r32 & 7) << 4)));
    bf16x8 b1 = *reinterpret_cast<const bf16x8*>(Ks + (32 + r32) * KP + (cb ^ ((r32 & 7) << 4)));
    const bf16x8 qv = d0 < NREG ? qr[d0 < NREG ? d0 : 0] : *reinterpret_cast<const bf16x8*>(ql + (d0 - NREG) * 1024);
    p0 = __builtin_amdgcn_mfma_f32_32x32x16_bf16(b0, qv, p0, 0, 0, 0);
    p1 = __builtin_amdgcn_mfma_f32_32x32x16_bf16(b1, qv, p1, 0, 0, 0); }
}
__device__ __forceinline__ int v_st(int k, int c) { const int kk = (k & ~0xC) | ((k & 4) << 1) | ((k & 8) >> 1); return ((kk >> 3) * 4 + (c >> 5)) * 512 + ((kk & 7) * 32 + (c & 31)) * 2; }
__device__ __forceinline__ int v_rd_base(int lane) { return ((lane & 3) << 3) | (((lane >> 2) & 3) << 6) | (((lane >> 4) & 1) << 5) | (((lane >> 5) & 1) << 8); }
constexpr int v_rd_off(int d0, int ks, int half) { return d0 * 512 + ks * 4096 + half * 2048; }
template <int OFF> __device__ __forceinline__ s16x4 tr_read(int vb) {
  s16x4 r; asm volatile("ds_read_b64_tr_b16 %0, %1 offset:%2" : "=&v"(r) : "v"(vb), "i"(OFF) : "memory"); return r;
}
template <int D0> __device__ __forceinline__ void pv_one(f32x16& od, int vb, bf16x8 pa0, bf16x8 pa1, bf16x8 pa2, bf16x8 pa3) {
  const s16x4 l0 = tr_read<v_rd_off(D0, 0, 0)>(vb), h0 = tr_read<v_rd_off(D0, 0, 1)>(vb), l1 = tr_read<v_rd_off(D0, 1, 0)>(vb), h1 = tr_read<v_rd_off(D0, 1, 1)>(vb);
  const s16x4 l2 = tr_read<v_rd_off(D0, 2, 0)>(vb), h2 = tr_read<v_rd_off(D0, 2, 1)>(vb), l3 = tr_read<v_rd_off(D0, 3, 0)>(vb), h3 = tr_read<v_rd_off(D0, 3, 1)>(vb);
  asm volatile("s_waitcnt lgkmcnt(0)" ::: "memory"); SBAR();
#define PK(L, H) (bf16x8){L[0], L[1], L[2], L[3], H[0], H[1], H[2], H[3]}
  od = __builtin_amdgcn_mfma_f32_32x32x16_bf16(pa0, PK(l0, h0), od, 0, 0, 0);
  od = __builtin_amdgcn_mfma_f32_32x32x16_bf16(pa1, PK(l1, h1), od, 0, 0, 0);
  od = __builtin_amdgcn_mfma_f32_32x32x16_bf16(pa2, PK(l2, h2), od, 0, 0, 0);
  od = __builtin_amdgcn_mfma_f32_32x32x16_bf16(pa3, PK(l3, h3), od, 0, 0, 0);
#undef PK
}
__device__ __forceinline__ void pv_d0(f32x16* o, int vb, bf16x8 pa0, bf16x8 pa1, bf16x8 pa2, bf16x8 pa3) {
  pv_one<0>(o[0], vb, pa0, pa1, pa2, pa3); pv_one<1>(o[1], vb, pa0, pa1, pa2, pa3); pv_one<2>(o[2], vb, pa0, pa1, pa2, pa3); pv_one<3>(o[3], vb, pa0, pa1, pa2, pa3);
}
__device__ __forceinline__ void na_mask(f32x16& p0, f32x16& p1, const float* bias  , int krow, int rq, int rs, int cq, int cs, int hi) {
  const bool rowok = (krow >= rs) && (krow <= rs + 7);
  int drow = krow - rq + 7; drow = drow < 0 ? 0 : (drow > 14 ? 14 : drow);
  const float* bt = bias + 64 + drow * 31 + (15 - cq + 4 * hi);
  const int kb = 4 * hi - cs;
#pragma unroll
  for (int r = 0; r < 16; ++r) { const int cr = (r & 3) + 8 * (r >> 2);
    const bool ok0 = rowok && (unsigned)(kb + cr) < 16u, ok1 = rowok && (unsigned)(kb + cr + 32) < 16u;
    const float b0 = bt[cr], b1 = bt[cr + 32];
    p0[r] = ok0 ? fmaf(p0[r], NA_SCALE, b0) : -INFINITY;
    p1[r] = ok1 ? fmaf(p1[r], NA_SCALE, b1) : -INFINITY; }
}

template <int MODE>
__device__ __forceinline__ void attn_unit(const bf16* __restrict__ Qb, int LDQ, const bf16* __restrict__ Kn, const bf16* __restrict__ Kr, const bf16* __restrict__ Vh, int LDK,
                                          bf16* __restrict__ Ob, int LDO, int kt0, int NT, char* lds, int r0, const float* __restrict__ rpb) {
  constexpr int ND0 = Cfg<MODE>::ND0, KP = Cfg<MODE>::KPITCH, SHM_K = Cfg<MODE>::SHM_K;
  const int tid = threadIdx.x, wid = tid >> 6, lane = tid & 63, r32 = lane & 31, hi = lane >> 5;
  char* V_lds = lds + OFF_V; char* K_lds = lds + OFF_K;
  float* ws = (float*)(lds + OFF_WS) + wid * 64; float* li_l = ws; float* al_l = ws + 32;
  float* bias_l = (float*)(lds + OFF_BIAS);
  constexpr int NQR = MODE == 0 ? ND0 - ATT_QLDS : ND0;
  float m_reg = -1e30f, l_reg = 0; f32x16 o[4] = {}; bf16x8 qr[NQR > 0 ? NQR : 1];
  const bf16* Qw = Qb + (long)(wid * QBLK + r32) * LDQ + hi * 8;
  char* ql = lds + OFF_QL + wid * (ATT_QLDS * 1024) + lane * 16;
#pragma unroll
  for (int d0 = 0; d0 < ND0; ++d0) { if (d0 < NQR) qr[d0 < NQR ? d0 : 0] = ld8(Qw + d0 * 16); else *reinterpret_cast<bf16x8*>(ql + (d0 - NQR) * 1024) = ld8(Qw + d0 * 16); }
  int rq = 0, rs = 0, cq = 0, cs = 0;
  if (MODE == 1) { rq = r0 + (wid >> 1); rs = rq - 4; rs = rs < 0 ? 0 : (rs > 120 ? 120 : rs); cq = (wid & 1) * 32 + r32; cs = cq - 8; cs = cs < 0 ? 0 : (cs > 48 ? 48 : cs);
    for (int i = tid; i < 15 * 31; i += 512) bias_l[64 + i] = rpb[i]; }
  const int sr = tid >> 4, sc = (tid & 15) * 8, vst0 = v_st(sr, sc), vst1 = v_st(32 + sr, sc);
  const int rr = tid >> 3, rc = (tid & 7) * 8;
  const int vb0 = (int)(uintptr_t)V_lds + v_rd_base(lane);
  const long k0g = (long)kt0 * KVBLK;
#ifndef ATT_SD
#define ATT_SD 1
#endif
#ifndef ATT_SIMPLE0
#define ATT_SIMPLE0 1
#endif
  struct { bf16x8 vs0, vs1, ks0, ks1, kr0; } sr_[ATT_SD];
#define SLOAD(i, kk) do { const long _k = k0g + (kk); sr_[i].vs0 = ld8(&Vh[(_k + sr) * LDK + sc]); sr_[i].vs1 = ld8(&Vh[(_k + 32 + sr) * LDK + sc]); \
    sr_[i].ks0 = ld8(&Kn[(_k + sr) * LDK + sc]); sr_[i].ks1 = ld8(&Kn[(_k + 32 + sr) * LDK + sc]); \
    if (MODE == 0) sr_[i].kr0 = ld8(&Kr[(_k + rr) * 64 + rc]); } while (0)
#define SWRITE(b, i) do { *(bf16x8*)(V_lds + (b) * SHM_V + vst0) = sr_[i].vs0;          \
    *(bf16x8*)(V_lds + (b) * SHM_V + vst1) = sr_[i].vs1; const int kc = sc * 2;               \
    *(bf16x8*)(K_lds + (b) * SHM_K + sr * KP + (kc ^ ((sr & 7) << 4))) = sr_[i].ks0;                       \
    *(bf16x8*)(K_lds + (b) * SHM_K + (32 + sr) * KP + (kc ^ ((sr & 7) << 4))) = sr_[i].ks1;            \
    if (MODE == 0) *(bf16x8*)(K_lds + (b) * SHM_K + rr * KP + ((256 + rc * 2) ^ ((rr & 7) << 4))) = sr_[i].kr0; } while (0)
#define SWAIT() do { if (ATT_SD == 1) asm volatile("s_waitcnt vmcnt(0)" ::: "memory"); else if (MODE == 0) asm volatile("s_waitcnt vmcnt(5)" ::: "memory"); else asm volatile("s_waitcnt vmcnt(4)" ::: "memory"); } while (0)
#define RESC(a) do { if (__any((a) < 1.f)) { if (hi == 0) al_l[r32] = (a); asm volatile("s_waitcnt lgkmcnt(0)" ::: "memory"); \
    _Pragma("unroll") for (int d = 0; d < 4; ++d) _Pragma("unroll") for (int r = 0; r < 16; ++r) o[d][r] *= al_l[crow(r, hi)]; } } while (0)
#define MASK(P0, P1, j) do { if (MODE == 1) na_mask(P0, P1, bias_l, kt0 + (j), rq, rs, cq, cs, hi); } while (0)
  bf16x8 pa0, pa1, pa2, pa3;
  if constexpr (MODE == 0 && ATT_SIMPLE0) {
    f32x16 pA0, pA1; float mnA, alA;
    SLOAD(0, 0); asm volatile("s_waitcnt vmcnt(0)" ::: "memory"); SWRITE(0, 0); __syncthreads();
    for (int j = 0; j < NT; ++j) {
      const int b = j & 1;
      if (j + 1 < NT) SLOAD(0, (j + 1) * KVBLK);
      SBAR(); qkt<MODE>(pA0, pA1, K_lds + b * SHM_K, qr, ql, r32, hi); MASK(pA0, pA1, j);
      partialSM<MODE>(pA0, pA1, m_reg, mnA, alA); RESC(alA);
      finishSM(pA0, pA1, alA, l_reg, pa0, pa1, pa2, pa3); SBAR();
      pv_d0(o, vb0 + b * SHM_V, pa0, pa1, pa2, pa3); SBAR();
      if (j + 1 < NT) SWRITE(b ^ 1, 0);
      __syncthreads();
    }
  } else {
  f32x16 pA0, pA1, pB0, pB1; float mnA, mnB, alA, alB; bf16x8 pa0, pa1, pa2, pa3;
  constexpr int SE = 0, SO = ATT_SD - 1;
  SLOAD(SE, 0); asm volatile("s_waitcnt vmcnt(0)" ::: "memory"); SWRITE(0, SE); __syncthreads();
  qkt<MODE>(pA0, pA1, K_lds, qr, ql, r32, hi); MASK(pA0, pA1, 0); partialSM<MODE>(pA0, pA1, m_reg, mnA, alA);
  SLOAD(SO, KVBLK); if (ATT_SD == 2) { if (2 < NT) SLOAD(SE, 2 * KVBLK); }
  SWAIT(); SWRITE(1, SO); __syncthreads();
  for (int j = 1; j + 1 < NT; j += 2) {
    SBAR(); qkt<MODE>(pB0, pB1, K_lds + SHM_K, qr, ql, r32, hi); MASK(pB0, pB1, j);
    finishSM(pA0, pA1, alA, l_reg, pa0, pa1, pa2, pa3); SBAR();
    SLOAD(SO, (j + ATT_SD) * KVBLK); SBAR();
    pv_d0(o, vb0, pa0, pa1, pa2, pa3); partialSM<MODE>(pB0, pB1, m_reg, mnB, alB);
    __syncthreads(); SWAIT(); SWRITE(0, SE);
    RESC(alB); __syncthreads();
    SBAR(); qkt<MODE>(pA0, pA1, K_lds, qr, ql, r32, hi); MASK(pA0, pA1, j + 1);
    finishSM(pB0, pB1, alB, l_reg, pa0, pa1, pa2, pa3); SBAR();
    if (ATT_SD == 1 || j + 3 < NT) SLOAD(SE, (j + 1 + ATT_SD) * KVBLK); SBAR();
    pv_d0(o, vb0 + SHM_V, pa0, pa1, pa2, pa3); partialSM<MODE>(pA0, pA1, m_reg, mnA, alA);
    __syncthreads(); SWAIT(); SWRITE(1, SO);
    RESC(alA); __syncthreads();
  }
  SBAR(); qkt<MODE>(pB0, pB1, K_lds + SHM_K, qr, ql, r32, hi); MASK(pB0, pB1, NT - 1);
  finishSM(pA0, pA1, alA, l_reg, pa0, pa1, pa2, pa3); SBAR();
  pv_d0(o, vb0, pa0, pa1, pa2, pa3); partialSM<MODE>(pB0, pB1, m_reg, mnB, alB);
  __syncthreads(); RESC(alB);
  finishSM(pB0, pB1, alB, l_reg, pa0, pa1, pa2, pa3); SBAR();
  pv_d0(o, vb0 + SHM_V, pa0, pa1, pa2, pa3);
  }
  if (hi == 0) li_l[r32] = l_reg; asm volatile("s_waitcnt lgkmcnt(0)" ::: "memory");
  float rli[16];
#pragma unroll
  for (int r = 0; r < 16; ++r) rli[r] = __builtin_amdgcn_rcpf(li_l[crow(r, hi)]);
  bf16* Ow = Ob + (long)(wid * QBLK) * LDO;
#pragma unroll
  for (int r = 0; r < 16; ++r) { const int orow = crow(r, hi);
#pragma unroll
    for (int d0 = 0; d0 < 4; ++d0) { const float v = o[d0][r] * rli[r]; Ow[(long)orow * LDO + d0 * 32 + r32] = (bf16)(cvtpk(v, v) & 0xffffu); } }
  __syncthreads();
#undef SLOAD
#undef SWRITE
#undef SWAIT
#undef RESC
#undef MASK
}
#undef SBAR
}

constexpr int NWAVES = 8;
constexpr int S = 8192, DM = 2048, INC = 3904, ZLD = 4096, DFF = 8192;
constexpr size_t MiB = 1u << 20;
constexpr size_t WS_CS = 0;
constexpr size_t WS_SSQ1 = 2 * MiB;
constexpr size_t WS_SSQ2 = WS_SSQ1 + 512 * 1024;
constexpr size_t WS_SSQ3 = WS_SSQ2 + 512 * 1024;
constexpr size_t WS_BAR = 3 * MiB + 512 * 1024;
constexpr size_t WS_WIN = 4 * MiB;
constexpr size_t WS_WUQ = 20 * MiB;
constexpr size_t WS_WUKV = 22 * MiB;
constexpr size_t WS_WOUT = 23 * MiB;
constexpr size_t WS_W1 = 31 * MiB;
constexpr size_t WS_W2 = 63 * MiB;
constexpr size_t WS_Z = 96 * MiB;
constexpr size_t WS_H = 160 * MiB;
constexpr size_t WS_Q = 160 * MiB;
constexpr size_t WS_KR = 184 * MiB;
constexpr size_t WS_KV = 192 * MiB;
constexpr size_t WS_MIX = 224 * MiB;
constexpr size_t WS_X1B = 96 * MiB;
constexpr size_t WS_U = 128 * MiB;
constexpr size_t WS_END = 256 * MiB;
constexpr int LDS_BYTES = 147456;
static_assert(att::ATTN_LDS_BYTES <= LDS_BYTES, "attention LDS");

#define GAS __attribute__((address_space(1)))
#define LAS __attribute__((address_space(3)))
typedef unsigned short bf16;
typedef unsigned v4u __attribute__((ext_vector_type(4)));
typedef float f32x4 __attribute__((ext_vector_type(4)));
typedef short bf16x8 __attribute__((ext_vector_type(8)));
#define LDS_WAIT() asm volatile("s_waitcnt lgkmcnt(0)" ::: "memory")
__device__ __forceinline__ unsigned f2bf(float f) { unsigned u = __builtin_bit_cast(unsigned, f); return (u + 0x7fffu + ((u >> 16) & 1u)) >> 16; }
__device__ __forceinline__ unsigned pk2(float lo, float hi) { return f2bf(lo) | (f2bf(hi) << 16); }
__device__ __forceinline__ float bf2f(unsigned short b) { return __builtin_bit_cast(float, (unsigned)b << 16); }
__device__ __forceinline__ float wave_sum(float v) {
#pragma unroll
    for (int o = 1; o < 64; o <<= 1) v += __shfl_xor(v, o);
    return v;
}
__device__ const float ROPE_INV[32] = {1.000000000e+00f, 7.498942614e-01f, 5.623413324e-01f, 4.216965139e-01f, 3.162277639e-01f, 2.371373773e-01f, 1.778279394e-01f, 1.333521307e-01f, 1.000000015e-01f, 7.498941571e-02f, 5.623413250e-02f, 4.216965288e-02f, 3.162277490e-02f, 2.371373773e-02f, 1.778279431e-02f, 1.333521493e-02f, 9.999999776e-03f, 7.498941850e-03f, 5.623413250e-03f, 4.216964822e-03f, 3.162277630e-03f, 2.371373586e-03f, 1.778279431e-03f, 1.333521446e-03f, 1.000000047e-03f, 7.498942432e-04f, 5.623413017e-04f, 4.216965172e-04f, 3.162277571e-04f, 2.371373703e-04f, 1.778279402e-04f, 1.333521504e-04f};
__device__ __forceinline__ void rope_cs(int pos, int i, float& c, float& s) {
    const float ang = (float)pos * ROPE_INV[i];
    const double t = (double)ang * 0.15915494309189535; const float fr = (float)(t - rint(t));
    s = __builtin_amdgcn_sinf(fr); c = __builtin_amdgcn_cosf(fr);
}

__device__ __forceinline__ int uq_perm(int n) { const int h = n / 192, d = n - h * 192; if (d < 128) return h * 128 + d; const int i = d - 128; return 1024 + h * 64 + ((i & 31) << 1) + (i >> 5); }
template <bool PERMQ>
__device__ __forceinline__ void p0_transpose_item(const float* __restrict__ W, const float* __restrict__ g, int K, int N, bf16* __restrict__ WT, LAS float* scr, int item, int lane) {
    const int nblk = N / 32, kb = item / nblk, nb = item % nblk, k0 = 64 * kb, n0 = 32 * nb;
#pragma unroll 8
    for (int i = 0; i < 32; ++i) { const int kk = 2 * i + (lane >> 5); float w = W[(size_t)(k0 + kk) * N + n0 + (lane & 31)]; if (g) w *= g[k0 + kk]; scr[kk * 33 + (lane & 31)] = w; }
    LDS_WAIT(); asm volatile("" ::: "memory");
    const int c = lane & 7;
#pragma unroll
    for (int j = 0; j < 4; ++j) { const int n = (lane >> 3) + 8 * j; const LAS float* s = scr + (8 * c) * 33 + n;
        v4u o; o.x = pk2(s[0 * 33], s[1 * 33]); o.y = pk2(s[2 * 33], s[3 * 33]); o.z = pk2(s[4 * 33], s[5 * 33]); o.w = pk2(s[6 * 33], s[7 * 33]);
        const int dn = PERMQ ? uq_perm(n0 + n) : (n0 + n);
        *(v4u*)(WT + (size_t)dn * K + k0 + 8 * c) = o; }
    LDS_WAIT(); asm volatile("" ::: "memory");
}
__device__ __forceinline__ void rms_row_to_bf16(const float* __restrict__ xrow, const float* __restrict__ g, bf16* __restrict__ orow, int lane) {
    const f32x4* xr = (const f32x4*)xrow + lane; const f32x4* gr = (const f32x4*)g + lane;
    f32x4 v[8]; float s = 0.f;
#pragma unroll
    for (int j = 0; j < 8; ++j) { v[j] = xr[64 * j]; s += pg8::dot4(v[j]); }
    const float rstd = 1.0f / sqrtf(wave_sum(s) * (1.f / 2048.f) + pg8::NORM_EPS);
    unsigned long long* o8 = (unsigned long long*)orow + lane;
#pragma unroll
    for (int j = 0; j < 8; ++j) { const f32x4 gg = gr[64 * j]; o8[64 * j] = (unsigned long long)pk2(v[j][0] * rstd * gg[0], v[j][1] * rstd * gg[1]) | ((unsigned long long)pk2(v[j][2] * rstd * gg[2], v[j][3] * rstd * gg[3]) << 32); }
}

#define XB_TMO      128
#define XB_XCNT(j)  (256  + 64 * (j))
#define XB_XSUB(j)  (1280 + 64 * (j))
#define XB_XGEN(j)  (2304 + 64 * (j))
#define XB_TOP      3328
#define XB_TOPGEN   3392
#define XCD_BAR_WORDS 3456
#define XB_SPIN_CAP (1u << 18)

__device__ __forceinline__ unsigned xb_ld(unsigned* p)              { return __hip_atomic_load(p, __ATOMIC_RELAXED, __HIP_MEMORY_SCOPE_AGENT); }
__device__ __forceinline__ unsigned xb_add(unsigned* p, unsigned v) { return __hip_atomic_fetch_add(p, v, __ATOMIC_RELAXED, __HIP_MEMORY_SCOPE_AGENT); }
__device__ __forceinline__ unsigned xb_xcc_id() { return (unsigned)__builtin_amdgcn_s_getreg((3 << 11) | 20) & 0xFu; }
#define XB_SPIN(cond, bar) do { unsigned _sp = 0; while (cond) { __builtin_amdgcn_s_sleep(1); \
    if ((++_sp & 255u) == 0u) { if (xb_ld(&(bar)[XB_TMO])) break; if (_sp > XB_SPIN_CAP) { atomicAdd(&(bar)[XB_TMO], 1u); break; } } } } while (0)

struct XcdBarrier {
    unsigned* bar; unsigned x;
    volatile LAS unsigned* st;
};

__device__ __forceinline__ XcdBarrier xcd_barrier_post(unsigned* bar, volatile LAS unsigned* st) {
    XcdBarrier b; b.bar = bar; b.x = xb_xcc_id(); b.st = st;
    if (threadIdx.x == 0) (void)xb_add(&bar[XB_XCNT(b.x)], 1u);
    return b;
}
__device__ __forceinline__ void xcd_barrier_complete(unsigned* bar, unsigned x, unsigned& nloc, unsigned& nx) {
    const unsigned G = gridDim.x * gridDim.y * gridDim.z;
    unsigned sum, cnt, mine, sp = 0u;
    for (;;) {
        sum = 0u; cnt = 0u; mine = 0u;
#pragma unroll
        for (unsigned j = 0; j < 16; ++j) { const unsigned c = xb_ld(&bar[XB_XCNT(j)]); sum += c; cnt += (c > 0u) ? 1u : 0u; mine = (j == x) ? c : mine; }
        if (sum == G) break;
        __builtin_amdgcn_s_sleep(1);
        if ((++sp & 255u) == 0u) { if (xb_ld(&bar[XB_TMO])) break; if (sp > XB_SPIN_CAP) { atomicAdd(&bar[XB_TMO], 1u); break; } }
    }
    nloc = mine > 0u ? mine : 1u; nx = cnt > 0u ? cnt : 1u;
}

__device__ __forceinline__ void xcd_barrier(const XcdBarrier& b) {
    asm volatile("s_waitcnt vmcnt(0)" ::: "memory");
    __syncthreads();
    if (threadIdx.x == 0) {
        unsigned* bar = b.bar;
        __builtin_amdgcn_s_waitcnt(0);
        unsigned nloc = b.st[0], nx = b.st[1];
        if (nloc == 0u) { xcd_barrier_complete(bar, b.x, nloc, nx); b.st[0] = nloc; b.st[1] = nx; }
        const unsigned old = xb_add(&bar[XB_XSUB(b.x)], 1u);
        const unsigned gen = old / nloc;
        if (old + 1u == (gen + 1u) * nloc) {
            __builtin_amdgcn_fence(__ATOMIC_RELEASE, "agent");
            asm volatile("s_waitcnt vmcnt(0)" ::: "memory");
            const unsigned og = xb_add(&bar[XB_TOP], 1u);
            const unsigned tg = og / nx;
            if (og + 1u == (tg + 1u) * nx) xb_add(&bar[XB_TOPGEN], 1u);
            else XB_SPIN(xb_ld(&bar[XB_TOPGEN]) == tg, bar);
            __builtin_amdgcn_fence(__ATOMIC_ACQUIRE, "agent");
            xb_add(&bar[XB_XGEN(b.x)], 1u);
            asm volatile("s_waitcnt vmcnt(0)" ::: "memory");
        } else {
            XB_SPIN(xb_ld(&bar[XB_XGEN(b.x)]) == gen, bar);
            __builtin_amdgcn_fence(__ATOMIC_ACQUIRE, "agent");
            asm volatile("s_waitcnt vmcnt(0)" ::: "memory");
        }
    }
    __syncthreads();
}

struct Args { const float* in[15]; float* out; unsigned char* ws; int ph_lo, ph_hi; };
constexpr int N_PHASES = 9;

__global__ void __launch_bounds__(NWAVES * 64, 2) mk_fwd(Args args) {
    extern __shared__ __attribute__((aligned(16))) unsigned char lds[];
    cg::grid_group grid = cg::this_grid();
    const int tid = threadIdx.x, lane = tid & 63, wave = __builtin_amdgcn_readfirstlane(tid >> 6);
    const int G = gridDim.x, bx = blockIdx.x;
    unsigned char* ws = args.ws;
    const float* x = args.in[0]; const float* attn_g = args.in[1]; const float* w_in = args.in[2]; const float* qn_g = args.in[3]; const float* w_uq = args.in[4];
    const float* kvn_g = args.in[5]; const float* w_ukv = args.in[6]; const float* rpb = args.in[7]; const float* mla_g = args.in[8]; const float* na_g = args.in[9];
    const float* w_out = args.in[10]; const float* mlp_g = args.in[11]; const float* w_ff1 = args.in[12]; const float* w_ff2 = args.in[13]; const float* fin_g = args.in[14];
    float* out = args.out;
    float* CS = (float*)(ws + WS_CS); float* SSQ1 = (float*)(ws + WS_SSQ1); float* SSQ2 = (float*)(ws + WS_SSQ2); float* SSQ3 = (float*)(ws + WS_SSQ3);
    bf16* WIN = (bf16*)(ws + WS_WIN); bf16* WUQ = (bf16*)(ws + WS_WUQ); bf16* WUKV = (bf16*)(ws + WS_WUKV); bf16* WOUT = (bf16*)(ws + WS_WOUT); bf16* W1 = (bf16*)(ws + WS_W1); bf16* W2 = (bf16*)(ws + WS_W2);
    bf16* Z = (bf16*)(ws + WS_Z); bf16* H = (bf16*)(ws + WS_H); bf16* Q = (bf16*)(ws + WS_Q); bf16* KR = (bf16*)(ws + WS_KR); bf16* KV = (bf16*)(ws + WS_KV);
    bf16* MIX = (bf16*)(ws + WS_MIX); bf16* X1B = (bf16*)(ws + WS_X1B); bf16* U = (bf16*)(ws + WS_U);
    const int lo = args.ph_lo, hi = args.ph_hi;
#ifndef PH_MASK
#define PH_MASK 0x1ff
#endif
#ifndef REP_MASK
#define REP_MASK 0
#endif
#ifndef EXTRA_SYNC
#define EXTRA_SYNC 0
#endif
#ifndef USE_XCDBAR
#define USE_XCDBAR 1
#endif
#define IN(k) ((((PH_MASK) >> (k)) & 1) && lo <= (k) && (k) < hi)
#define GBAR() do { if (USE_XCDBAR && xb_ready) xcd_barrier(xbar); else { grid.sync(); if (USE_XCDBAR) { xbar = xcd_barrier_post(barw, (volatile LAS unsigned*)(ldsp + 131072 + 512)); xb_ready = true; } } } while (0)
#define SEAM(k) do { if (IN(k) && IN((k) + 1)) { GBAR(); for (int xs_ = 0; xs_ < EXTRA_SYNC; ++xs_) GBAR(); } } while (0)
#define NREP(k) ((((REP_MASK) >> (k)) & 1) ? 2 : 1)
    const int gw = bx * NWAVES + wave, NGW = G * NWAVES;
    PG8_LAS unsigned char* ldsp = (PG8_LAS unsigned char*)lds;
    unsigned* barw = (unsigned*)(ws + WS_BAR); XcdBarrier xbar; xbar.bar = barw; xbar.x = 0; xbar.st = nullptr; bool xb_ready = false;
    if (USE_XCDBAR) {
        if (tid < 2) ((volatile LAS unsigned*)(ldsp + 131072 + 512))[tid] = 0u;
        if (bx == 0) for (int i = tid; i < XCD_BAR_WORDS; i += NWAVES * 64) __hip_atomic_store(barw + i, 0u, __ATOMIC_RELAXED, __HIP_MEMORY_SCOPE_AGENT);
        __syncthreads();
    }

    if (IN(0)) for (int rep_ = 0; rep_ < NREP(0); ++rep_) { if (rep_) GBAR();
        LAS float* scr = (LAS float*)(ldsp + wave * 16384);
        constexpr int I_IN = (DM / 64) * (INC / 32), I_UQ = (512 / 64) * (1536 / 32), I_UKV = (256 / 64) * (2048 / 32), I_OUT = (DM / 64) * (DM / 32), I_1 = (DM / 64) * (DFF / 32), I_2 = (DFF / 64) * (DM / 32);
        constexpr int NITEMS = I_IN + I_UQ + I_UKV + I_OUT + I_1 + I_2;
        for (int it = gw; it < NITEMS; it += NGW) {
            int r = it;
            if (r < I_IN) { p0_transpose_item<false>(w_in, nullptr, DM, INC, WIN, scr, r, lane); continue; } r -= I_IN;
            if (r < I_UQ) { p0_transpose_item<true>(w_uq, qn_g, 512, 1536, WUQ, scr, r, lane); continue; } r -= I_UQ;
            if (r < I_UKV) { p0_transpose_item<false>(w_ukv, kvn_g, 256, 2048, WUKV, scr, r, lane); continue; } r -= I_UKV;
            if (r < I_OUT) { p0_transpose_item<false>(w_out, nullptr, DM, DM, WOUT, scr, r, lane); continue; } r -= I_OUT;
            if (r < I_1) { p0_transpose_item<false>(w_ff1, mlp_g, DM, DFF, W1, scr, r, lane); continue; } r -= I_1;
            p0_transpose_item<false>(w_ff2, nullptr, DFF, DM, W2, scr, r, lane);
        }
        for (int i = bx * 512 + tid; i < 192 * 2048 / 8; i += G * 512) ((v4u*)(WIN + (size_t)INC * DM))[i] = (v4u){0u, 0u, 0u, 0u};
        for (int m = gw; m < S; m += NGW) rms_row_to_bf16(x + (size_t)m * DM, attn_g, H + (size_t)m * DM, lane);
        for (int e = bx * 512 + tid; e < S * 32; e += G * 512) { float c, s; rope_cs(e >> 5, e & 31, c, s); CS[2 * e] = c; CS[2 * e + 1] = s; }
    }
    SEAM(0);
    if (IN(1)) for (int rep_ = 0; rep_ < NREP(1); ++rep_) { if (rep_) GBAR();
        pg8::Gemm g{H, WIN, S, ZLD, DM, DM, DM}; pg8::StaticOrder So; So.init(S, ZLD, G, bx);
        pg8::EpiZ E{Z, SSQ1};
        pg8::gemm_phase<pg8::EpiZ, pg8::StaticOrder, true, true>(ldsp, g, So, E);
    }
    SEAM(1);
    if (IN(2)) for (int rep_ = 0; rep_ < NREP(2); ++rep_) { if (rep_) GBAR();
        { pg8::Gemm g{Z, WUQ, S, 1536, 512, ZLD, 512}; pg8::StaticOrder So; So.init(S, 1536, G, bx);
          pg8::EpiQ E{Q, SSQ1, CS};
          pg8::gemm_phase<pg8::EpiQ, pg8::StaticOrder, true, true>(ldsp, g, So, E); }
        { pg8::Gemm g{Z + 512, WUKV, S, 2048, 256, ZLD, 256}; pg8::StaticOrder So; So.init(S, 2048, G, bx);
          pg8::EpiKV E{KV, SSQ1};
          pg8::gemm_phase<pg8::EpiKV, pg8::StaticOrder, true, true>(ldsp, g, So, E); }
        for (int e = bx * 512 + tid; e < S * 32; e += G * 512) { const int pos = e >> 5, i = e & 31;
            const float x1 = bf2f(Z[(size_t)pos * ZLD + 768 + i]), x2 = bf2f(Z[(size_t)pos * ZLD + 800 + i]); const float c = CS[2 * e], s = CS[2 * e + 1];
            ((unsigned*)KR)[e] = pk2(x1 * c - x2 * s, x1 * s + x2 * c); }
    }
    SEAM(2);
    if (IN(3)) for (int rep_ = 0; rep_ < NREP(3); ++rep_) { if (rep_) GBAR();
#ifndef ATT_MASK
#define ATT_MASK 3
#endif
        if (ATT_MASK & 1) for (int u = bx; u < 256; u += G) { const int h = u & 7, qb = u >> 3;
            att::attn_unit<0>(Q + (size_t)qb * 256 * 1536 + h * 192, 1536, KV + h * 256, KR, KV + h * 256 + 128, 2048, MIX + (size_t)qb * 256 * 2048 + h * 128, 2048, 0, S / 64, (char*)lds, 0, nullptr); }
        if (ATT_MASK & 2) for (int u = bx; u < 256; u += G) { const int h = u & 7, qb = u >> 3, r0 = 4 * qb;
            int t0 = r0 - 4; t0 = t0 < 0 ? 0 : (t0 > 120 ? 120 : t0); int t1 = r0 + 3 - 4; t1 = (t1 < 0 ? 0 : (t1 > 120 ? 120 : t1)) + 7; int nt = t1 - t0 + 1; if (nt & 1) ++nt;
            att::attn_unit<1>(Z + (size_t)qb * 256 * ZLD + 832 + h * 128, ZLD, Z + 1856 + h * 128, nullptr, Z + 2880 + h * 128, ZLD, MIX + (size_t)qb * 256 * 2048 + 1024 + h * 128, 2048, t0, nt, (char*)lds, r0, rpb + h * 465); }
    }
    SEAM(3);
    if (IN(4)) for (int rep_ = 0; rep_ < NREP(4); ++rep_) { if (rep_) GBAR();
        for (int m = gw; m < S; m += NGW) {
#pragma unroll
            for (int half = 0; half < 2; ++half) { bf16* rowp = MIX + (size_t)m * 2048 + half * 1024 + lane * 16; const float* gp = (half ? na_g : mla_g) + lane * 16;
                const bf16x8 a = *(const bf16x8*)rowp, b = *(const bf16x8*)(rowp + 8); float v[16]; float s = 0.f;
#pragma unroll
                for (int j = 0; j < 8; ++j) { v[j] = bf2f((unsigned short)a[j]); v[8 + j] = bf2f((unsigned short)b[j]); }
#pragma unroll
                for (int j = 0; j < 16; ++j) s += v[j] * v[j];
                const float rstd = 1.0f / sqrtf(wave_sum(s) * (1.f / 1024.f) + pg8::NORM_EPS);
                v4u o0, o1; const f32x4 g0 = *(const f32x4*)gp, g1 = *(const f32x4*)(gp + 4), g2 = *(const f32x4*)(gp + 8), g3 = *(const f32x4*)(gp + 12);
                o0.x = pk2(v[0] * rstd * g0[0], v[1] * rstd * g0[1]); o0.y = pk2(v[2] * rstd * g0[2], v[3] * rstd * g0[3]); o0.z = pk2(v[4] * rstd * g1[0], v[5] * rstd * g1[1]); o0.w = pk2(v[6] * rstd * g1[2], v[7] * rstd * g1[3]);
                o1.x = pk2(v[8] * rstd * g2[0], v[9] * rstd * g2[1]); o1.y = pk2(v[10] * rstd * g2[2], v[11] * rstd * g2[3]); o1.z = pk2(v[12] * rstd * g3[0], v[13] * rstd * g3[1]); o1.w = pk2(v[14] * rstd * g3[2], v[15] * rstd * g3[3]);
                *(v4u*)rowp = o0; *(v4u*)(rowp + 8) = o1; }
        }
    }
    SEAM(4);
    if (IN(5)) for (int rep_ = 0; rep_ < NREP(5); ++rep_) { if (rep_) GBAR();
        pg8::Gemm g{MIX, WOUT, S, DM, DM, DM, DM}; pg8::StaticOrder So; So.init(S, DM, G, bx);
        pg8::EpiRes<true> E{x, out, X1B, SSQ2};
        for (int i = 0; ; ++i) { pg8::Unit uu; if (!So.next(i, uu)) break; pg8::OneUnit O1{uu}; pg8::gemm_phase<pg8::EpiRes<true>, pg8::OneUnit, false, true>(ldsp, g, O1, E); }
    }
    SEAM(5);
    if (IN(6)) for (int rep_ = 0; rep_ < NREP(6); ++rep_) { if (rep_) GBAR();
        pg8::Gemm g{X1B, W1, S, DFF, DM, DM, DM}; pg8::StaticOrder So; So.init(S, DFF, G, bx);
        pg8::EpiFF1 E{U, SSQ2};
        pg8::gemm_phase<pg8::EpiFF1, pg8::StaticOrder, true, true>(ldsp, g, So, E);
    }
    SEAM(6);
    if (IN(7)) for (int rep_ = 0; rep_ < NREP(7); ++rep_) { if (rep_) GBAR();
        pg8::Gemm g{U, W2, S, DM, DFF, DFF, DFF}; pg8::StaticOrder So; So.init(S, DM, G, bx);
        pg8::EpiRes<false> E{out, out, nullptr, SSQ3};
        for (int i = 0; ; ++i) { pg8::Unit uu; if (!So.next(i, uu)) break; pg8::OneUnit O1{uu}; pg8::gemm_phase<pg8::EpiRes<false>, pg8::OneUnit, false, true>(ldsp, g, O1, E); }
    }
    SEAM(7);
    if (IN(8)) for (int rep_ = 0; rep_ < NREP(8); ++rep_) { if (rep_) GBAR();
        for (int m = gw; m < S; m += NGW) {
            const f32x4 sa = *(const f32x4*)(SSQ3 + (size_t)m * 8), sb = *(const f32x4*)(SSQ3 + (size_t)m * 8 + 4);
            const float rstd = 1.0f / sqrtf(((sa[0] + sa[1]) + (sa[2] + sa[3]) + (sb[0] + sb[1]) + (sb[2] + sb[3])) * (1.0f / 2048.0f) + pg8::NORM_EPS);
            f32x4* xr = (f32x4*)(out + (size_t)m * DM) + lane; const f32x4* gr = (const f32x4*)fin_g + lane;
#pragma unroll
            for (int j = 0; j < 8; ++j) { const f32x4 v = xr[64 * j], gg = gr[64 * j]; xr[64 * j] = v * rstd * gg; }
        }
    }
#undef IN
#undef SEAM
}

extern "C" void kernel_launch(void* const* d_in, const int* in_sizes, int n_in, void* d_out, int out_size, void* d_ws, size_t ws_size, hipStream_t stream) {
    static int grid = 0;
    if (grid == 0) {
        if (n_in != 15 || in_sizes[0] != S * DM || out_size != S * DM || ws_size < WS_END) { fprintf(stderr, "kernel_launch: unexpected shapes (n_in %d, in0 %d, out %d, ws %zu)\n", n_in, n_in > 0 ? in_sizes[0] : -1, out_size, ws_size); grid = -1; return; }
        int dev = 0, cus = 0, per_cu = 0;
        if (hipGetDevice(&dev) != hipSuccess || hipDeviceGetAttribute(&cus, hipDeviceAttributeMultiprocessorCount, dev) != hipSuccess) { grid = -1; return; }
        if (hipFuncSetAttribute((const void*)mk_fwd, hipFuncAttributeMaxDynamicSharedMemorySize, LDS_BYTES) != hipSuccess) { fprintf(stderr, "kernel_launch: hipFuncSetAttribute failed\n"); grid = -1; return; }
        if (hipOccupancyMaxActiveBlocksPerMultiprocessor(&per_cu, (const void*)mk_fwd, NWAVES * 64, LDS_BYTES) != hipSuccess || per_cu < 1) { fprintf(stderr, "kernel_launch: occupancy query failed (%d)\n", per_cu); (void)hipGetLastError(); per_cu = 1; }
        grid = cus * per_cu;
    }
    if (grid < 0) return;
    Args a{};
    for (int i = 0; i < 15; ++i) a.in[i] = (const float*)d_in[i];
    a.out = (float*)d_out; a.ws = (unsigned char*)d_ws;
#if MK_N_LAUNCHES == 1
    a.ph_lo = 0; a.ph_hi = N_PHASES;
    void* kargs[] = {&a};
    const hipError_t e = hipLaunchCooperativeKernel((const void*)mk_fwd, dim3(grid), dim3(NWAVES * 64), kargs, LDS_BYTES, stream);
    if (e != hipSuccess) fprintf(stderr, "kernel_launch: cooperative launch failed: %s (grid %d)\n", hipGetErrorString(e), grid);
#else
    for (int p = 0; p < N_PHASES; ++p) { a.ph_lo = p; a.ph_hi = p + 1; hipLaunchKernelGGL(mk_fwd, dim3(grid), dim3(NWAVES * 64), LDS_BYTES, stream, a); }
#endif
}
```

```cpp
#define ATT_SIMPLE0 0
#define ATT_SD 1
#define ATT_QLDS 5
#include <hip/hip_runtime.h>
#include <hip/hip_cooperative_groups.h>
#include <hip/hip_bf16.h>
#include <cstdio>
#include <cstdint>
#include <cmath>
namespace cg = cooperative_groups;

#ifndef MK_N_LAUNCHES
#define MK_N_LAUNCHES 1
#endif

namespace pg8 {
#define PG8_LAS __attribute__((address_space(3)))
typedef unsigned short bf16_t;
typedef short bf16x8 __attribute__((ext_vector_type(8)));
typedef float f32x4 __attribute__((ext_vector_type(4)));
typedef float f32x2 __attribute__((ext_vector_type(2)));
typedef unsigned u32x4 __attribute__((ext_vector_type(4)));
typedef unsigned u32x2 __attribute__((ext_vector_type(2)));
constexpr int BM = 256, BK = 64, HALF = 128, HTB = HALF * BK * 2  , STAGE_BYTES = 8 * HTB, NXCD = 8, WGM = 8;

__host__ __device__ __forceinline__ int lds_byte(int r, int c) { const int st = (r >> 4) * 2 + (c >> 5), rr = r & 15, cc = c & 31, ob = rr * 64 + cc * 2; return st * 1024 + (ob ^ (((ob >> 9) & 1) << 5)); }
__host__ __device__ __forceinline__ void stage_rc(int b, int& R, int& C) { const int st = b / 1024, sb = b % 1024, swz = sb ^ (((sb >> 9) & 1) << 5); R = (st >> 1) * 16 + swz / 64; C = (st & 1) * 32 + (swz % 64) / 2; }
__host__ __device__ __forceinline__ int perm32(int rho) { const int n = rho >> 4, i = rho & 15; return 8 * (i >> 2) + 4 * n + (i & 3); }

struct Unit { int pm, pn; };
struct Gemm { const bf16_t* A; const bf16_t* Bt; int M, N, K, lda, ldb; };

struct StaticOrder {
    int nM, nN, nwg, G, c;
    __host__ __device__ void init(int M, int N, int G_, int c_) { nM = M / BM; nN = N / BM; nwg = nM * nN; G = G_; c = c_; }
    __host__ __device__ bool next(int i, Unit& u) const {
        const long L = (long)i * G + c; if (L >= nwg) return false;
        int wgid = (int)L; { const int q = nwg / NXCD, r = nwg % NXCD, xcd = wgid % NXCD, off = wgid / NXCD; wgid = (xcd < r ? xcd * (q + 1) : r * (q + 1) + (xcd - r) * q) + off; }
        const int nig = WGM * nN, gid = wgid / nig, fm = gid * WGM, gsz = (nM - fm) < WGM ? (nM - fm) : WGM;
        u.pm = fm + ((wgid % nig) % gsz); u.pn = (wgid % nig) / gsz; return true;
    }
    __device__ __forceinline__ void a_ready(const Unit&) const {}
    __device__ __forceinline__ void done(const Unit&) const {}
};

struct OneUnit { Unit u;
    __device__ __forceinline__ bool next(int i, Unit& o) const { if (i != 0) return false; o = u; return true; }
    __device__ __forceinline__ void a_ready(const Unit&) const {}
    __device__ __forceinline__ void done(const Unit&) const {}
};

__device__ __forceinline__ unsigned cvt_pk_bf16(float lo, float hi) { unsigned r; asm volatile("v_cvt_pk_bf16_f32 %0, %1, %2" : "=v"(r) : "v"(lo), "v"(hi)); return r; }
constexpr float NORM_EPS = 1e-6f;

__device__ __forceinline__ u32x4 pack8(f32x4 v0, f32x4 v1) { u32x4 w; w.x = cvt_pk_bf16(v0[0], v0[1]); w.y = cvt_pk_bf16(v0[2], v0[3]); w.z = cvt_pk_bf16(v1[0], v1[1]); w.w = cvt_pk_bf16(v1[2], v1[3]); return w; }
__device__ __forceinline__ float dot4(f32x4 v) { return (v[0] * v[0] + v[1] * v[1]) + (v[2] * v[2] + v[3] * v[3]); }

struct EpiZ {
    static constexpr bool PERM = true, AFTER_DRAIN = false;
    bf16_t* Z; float* ssq;
    __device__ __forceinline__ void operator()(const f32x4 (&acc)[2][2][4][2], const Unit& u, int wr, int wc, int fr, int fq) const {
        const int row0 = u.pm * BM + wr * 64 + fr, col0 = u.pn * BM + wc * 32 + 8 * fq;
#pragma unroll
        for (int ai = 0; ai < 2; ++ai)
#pragma unroll
            for (int m = 0; m < 4; ++m) { const int row = row0 + ai * HALF + m * 16; bf16_t* rowp = Z + (size_t)row * 4096 + col0; float s = 0.f;
#pragma unroll
                for (int bj = 0; bj < 2; ++bj) { const f32x4 v0 = acc[ai][bj][m][0], v1 = acc[ai][bj][m][1]; s += dot4(v0) + dot4(v1); *(u32x4*)(rowp + bj * HALF) = pack8(v0, v1); }
                if (u.pn < 3) { s += __shfl_xor(s, 16); s += __shfl_xor(s, 32); if (fq == 0) ssq[(size_t)row * 12 + u.pn * 4 + wc] = s; } }
    }
};
struct EpiQ {
    static constexpr bool PERM = true, AFTER_DRAIN = false;
    bf16_t* Q; const float* ssq; const float* cs;
    __device__ __forceinline__ void operator()(const f32x4 (&acc)[2][2][4][2], const Unit& u, int wr, int wc, int fr, int fq) const {
        const int row0 = u.pm * BM + wr * 64 + fr, col0 = u.pn * BM + wc * 32 + 8 * fq;
#pragma unroll
        for (int ai = 0; ai < 2; ++ai)
#pragma unroll
            for (int m = 0; m < 4; ++m) { const int row = row0 + ai * HALF + m * 16;
                const f32x4 sa = *(const f32x4*)(ssq + (size_t)row * 12), sb = *(const f32x4*)(ssq + (size_t)row * 12 + 4);
                const float rstd = 1.0f / sqrtf(((sa[0] + sa[1]) + (sa[2] + sa[3]) + (sb[0] + sb[1]) + (sb[2] + sb[3])) * (1.0f / 512.0f) + NORM_EPS);
#pragma unroll
                for (int bj = 0; bj < 2; ++bj) { f32x4 v0 = acc[ai][bj][m][0] * rstd, v1 = acc[ai][bj][m][1] * rstd; const int colg = col0 + bj * HALF; bf16_t* dst;
                    if (u.pn >= 4) { const int cr = colg - 1024, head = cr >> 6, jj = cr & 63;
                        const f32x4 c0 = *(const f32x4*)(cs + (size_t)row * 64 + jj), c1 = *(const f32x4*)(cs + (size_t)row * 64 + jj + 4);
                        f32x4 w0, w1;
                        w0[0] = v0[0] * c0[0] - v0[1] * c0[1]; w0[1] = v0[0] * c0[1] + v0[1] * c0[0]; w0[2] = v0[2] * c0[2] - v0[3] * c0[3]; w0[3] = v0[2] * c0[3] + v0[3] * c0[2];
                        w1[0] = v1[0] * c1[0] - v1[1] * c1[1]; w1[1] = v1[0] * c1[1] + v1[1] * c1[0]; w1[2] = v1[2] * c1[2] - v1[3] * c1[3]; w1[3] = v1[2] * c1[3] + v1[3] * c1[2];
                        v0 = w0; v1 = w1; dst = Q + (size_t)row * 1536 + head * 192 + 128 + jj; }
                    else { const int head = colg >> 7, d = colg & 127; dst = Q + (size_t)row * 1536 + head * 192 + d; }
                    *(u32x4*)dst = pack8(v0, v1); }
                asm volatile("" ::: "memory"); }
    }
};
struct EpiKV {
    static constexpr bool PERM = true, AFTER_DRAIN = false;
    bf16_t* KV; const float* ssq;
    __device__ __forceinline__ void operator()(const f32x4 (&acc)[2][2][4][2], const Unit& u, int wr, int wc, int fr, int fq) const {
        const int row0 = u.pm * BM + wr * 64 + fr, col0 = u.pn * BM + wc * 32 + 8 * fq;
#pragma unroll
        for (int ai = 0; ai < 2; ++ai)
#pragma unroll
            for (int m = 0; m < 4; ++m) { const int row = row0 + ai * HALF + m * 16;
                const f32x4 sa = *(const f32x4*)(ssq + (size_t)row * 12 + 8);
                const float rstd = 1.0f / sqrtf(((sa[0] + sa[1]) + (sa[2] + sa[3])) * (1.0f / 256.0f) + NORM_EPS);
                bf16_t* rowp = KV + (size_t)row * 2048 + col0;
#pragma unroll
                for (int bj = 0; bj < 2; ++bj) *(u32x4*)(rowp + bj * HALF) = pack8(acc[ai][bj][m][0] * rstd, acc[ai][bj][m][1] * rstd); }
    }
};
struct EpiFF1 {
    static constexpr bool PERM = true, AFTER_DRAIN = false;
    bf16_t* U; const float* ssq2;
    __device__ __forceinline__ void operator()(const f32x4 (&acc)[2][2][4][2], const Unit& u, int wr, int wc, int fr, int fq) const {
        const int row0 = u.pm * BM + wr * 64 + fr, col0 = u.pn * BM + wc * 32 + 8 * fq;
#pragma unroll
        for (int ai = 0; ai < 2; ++ai)
#pragma unroll
            for (int m = 0; m < 4; ++m) { const int row = row0 + ai * HALF + m * 16;
                const f32x4 sa = *(const f32x4*)(ssq2 + (size_t)row * 8), sb = *(const f32x4*)(ssq2 + (size_t)row * 8 + 4);
                const float rstd = 1.0f / sqrtf(((sa[0] + sa[1]) + (sa[2] + sa[3]) + (sb[0] + sb[1]) + (sb[2] + sb[3])) * (1.0f / 2048.0f) + NORM_EPS);
                bf16_t* rowp = U + (size_t)row * 8192 + col0;
#pragma unroll
                for (int bj = 0; bj < 2; ++bj) { f32x4 v0 = acc[ai][bj][m][0] * rstd, v1 = acc[ai][bj][m][1] * rstd;
#pragma unroll
                    for (int j = 0; j < 4; ++j) { const float a = fmaxf(v0[j], 0.f), b = fmaxf(v1[j], 0.f); v0[j] = a * a; v1[j] = b * b; }
                    *(u32x4*)(rowp + bj * HALF) = pack8(v0, v1); } }
    }
};
template <bool WRITE_B> struct EpiRes {
    static constexpr bool PERM = false, AFTER_DRAIN = true;
    const float* base; float* out; bf16_t* xb; float* ssq;
    __device__ __forceinline__ void fused(f32x4 (&acc)[2][2][4][2], const Unit& u, int wr, int wc, int fr, int fq, PG8_LAS unsigned char* lds, int wid, int lane) const {
        PG8_LAS float* P = (PG8_LAS float*)lds;
        const int col0 = u.pn * BM + wc * 32 + 4 * fq;
#pragma unroll
        for (int ai = 0; ai < 2; ++ai)
#pragma unroll
            for (int m = 0; m < 4; ++m) { const int r = ai * HALF + wr * 64 + m * 16 + fr; const size_t off = (size_t)(u.pm * BM + r) * 2048 + col0; float s = 0.f;
#pragma unroll
                for (int bj = 0; bj < 2; ++bj)
#pragma unroll
                    for (int n = 0; n < 2; ++n) { const f32x4 v = *(const f32x4*)(base + off + bj * HALF + n * 16) + acc[ai][bj][m][n]; s += dot4(v);
                        *(f32x4*)(out + off + bj * HALF + n * 16) = v;
                        if (WRITE_B) { u32x2 w; w.x = cvt_pk_bf16(v[0], v[1]); w.y = cvt_pk_bf16(v[2], v[3]); *(u32x2*)(xb + off + bj * HALF + n * 16) = w; } }
                s += __shfl_xor(s, 16); s += __shfl_xor(s, 32);
                if (fq == 0) P[r * 4 + wc] = s;
                if (m & 1) asm volatile("" ::: "memory"); }
        asm volatile("s_waitcnt lgkmcnt(0)" ::: "memory"); __builtin_amdgcn_s_barrier(); asm volatile("" ::: "memory");
        const int t = wid * 64 + lane;
        if (t < 256) ssq[(size_t)(u.pm * BM + t) * 8 + u.pn] = (P[t * 4 + 0] + P[t * 4 + 1]) + (P[t * 4 + 2] + P[t * 4 + 3]);
        asm volatile("s_waitcnt lgkmcnt(0)" ::: "memory"); __builtin_amdgcn_s_barrier(); asm volatile("" ::: "memory");
    }
};

template <class Epi, class Sched, bool ALIGN_EPI = false, bool SP2 = false>
__device__ __forceinline__ void gemm_phase(PG8_LAS unsigned char* lds, const Gemm g, const Sched& S, const Epi& E) {
    const int tid = threadIdx.x, wid = __builtin_amdgcn_readfirstlane(tid >> 6), lane = tid & 63, wr = wid >> 2, wc = wid & 3, fr = lane & 15, fq = lane >> 4;
    const int K = g.K, nt = K / BK;
    unsigned voffA[2], voffB[2];
#pragma unroll
    for (int i = 0; i < 2; ++i) { int R, C; stage_rc(tid * 16 + i * 8192, R, C); const int Rb = Epi::PERM ? ((R & ~31) + perm32(R & 31)) : R;
        voffA[i] = (unsigned)(R * g.lda + C) * 2u; voffB[i] = (unsigned)(Rb * g.ldb + C) * 2u; }
    const size_t kstep = (size_t)(BK * 2);
    const size_t hstepA = (size_t)HALF * g.lda * 2, hstepB = (size_t)HALF * g.ldb * 2;
    const size_t tstepA = 2 * hstepA, tstepB = 2 * hstepB;
    const unsigned ldsw = (unsigned)wid * 1024u;
    const int aoff = lds_byte(wr * 64 + fr, fq * 8), boff = lds_byte(wc * 32 + fr, fq * 8);
#define PG8_SA(b, h) (((b) * 2 + (h)) * HTB)
#define PG8_SB(b, h) ((4 + (b) * 2 + (h)) * HTB)
#define PG8_STAGE(bufoff, gbase, voff) do { _Pragma("unroll") for (int _i = 0; _i < 2; ++_i) \
        __builtin_amdgcn_global_load_lds((const unsigned*)((const char*)(gbase) + (voff)[_i]), (PG8_LAS unsigned*)(lds + (bufoff) + ldsw + _i * 8192), 16, 0, 0); } while (0)
#define PG8_LDA(dst, b, h) do { _Pragma("unroll") for (int m = 0; m < 4; ++m) _Pragma("unroll") for (int k = 0; k < 2; ++k) dst[m][k] = *(const PG8_LAS bf16x8*)(lds + PG8_SA(b, h) + aoff + m * 2048 + k * 1024); } while (0)
#define PG8_LDB(dst, b, h) do { _Pragma("unroll") for (int n = 0; n < 2; ++n) _Pragma("unroll") for (int k = 0; k < 2; ++k) dst[n][k] = *(const PG8_LAS bf16x8*)(lds + PG8_SB(b, h) + boff + n * 2048 + k * 1024); } while (0)
#define PG8_MMA(ai, bj, At, Bt) do { __builtin_amdgcn_s_setprio(1); _Pragma("unroll") for (int m = 0; m < 4; ++m) _Pragma("unroll") for (int n = 0; n < 2; ++n) _Pragma("unroll") for (int k = 0; k < 2; ++k) \
        acc[ai][bj][m][n] = __builtin_amdgcn_mfma_f32_16x16x32_bf16(Bt[n][k], At[m][k], acc[ai][bj][m][n], 0, 0, 0); __builtin_amdgcn_s_setprio(0); } while (0)
#define PG8_WAIT_V(n) asm volatile("s_waitcnt vmcnt(" #n ")" ::: "memory")
#define PG8_WAIT_L(n) asm volatile("s_waitcnt lgkmcnt(" #n ")" ::: "memory")
#define PG8_BAR __builtin_amdgcn_s_barrier()
#define PG8_SCHED __builtin_amdgcn_sched_barrier(0)
    Unit cur, nxt; int ui = 0;
    if (!S.next(0, cur)) return;
    f32x4 acc[2][2][4][2];
#pragma unroll
    for (int a = 0; a < 2; ++a)
#pragma unroll
        for (int b = 0; b < 2; ++b)
#pragma unroll
            for (int m = 0; m < 4; ++m)
#pragma unroll
                for (int n = 0; n < 2; ++n) acc[a][b][m][n] = (f32x4){0.f, 0.f, 0.f, 0.f};
    bf16x8 At[4][2], B0[2][2], B1[2][2];
    const char* cA = (const char*)g.A + (size_t)cur.pm * tstepA; const char* cB = (const char*)g.Bt + (size_t)cur.pn * tstepB;
    S.a_ready(cur);
    if constexpr (SP2) {
        PG8_STAGE(PG8_SB(0, 0), cB, voffB); PG8_STAGE(PG8_SB(0, 1), cB + hstepB, voffB); PG8_STAGE(PG8_SA(0, 0), cA, voffA); PG8_STAGE(PG8_SA(0, 1), cA + hstepA, voffA);
        if (wr == 1) PG8_BAR;
        PG8_WAIT_V(2); PG8_BAR;
        PG8_STAGE(PG8_SB(1, 0), cB + kstep, voffB); PG8_STAGE(PG8_SA(1, 0), cA + kstep, voffA); PG8_STAGE(PG8_SB(1, 1), cB + hstepB + kstep, voffB);
        PG8_WAIT_V(6); PG8_BAR;
    } else {
        PG8_STAGE(PG8_SB(0, 0), cB, voffB); PG8_STAGE(PG8_SA(0, 0), cA, voffA); PG8_STAGE(PG8_SB(0, 1), cB + hstepB, voffB); PG8_STAGE(PG8_SA(0, 1), cA + hstepA, voffA);
        if (wr == 1) PG8_BAR;
        PG8_WAIT_V(4); PG8_BAR;
        PG8_STAGE(PG8_SB(1, 0), cB + kstep, voffB); PG8_STAGE(PG8_SA(1, 0), cA + kstep, voffA); PG8_STAGE(PG8_SB(1, 1), cB + hstepB + kstep, voffB);
        PG8_WAIT_V(6); PG8_BAR;
    }
    for (;;) {
        const bool has_next = S.next(ui + 1, nxt);
        const char* nA = has_next ? (const char*)g.A + (size_t)nxt.pm * tstepA : cA; const char* nB = has_next ? (const char*)g.Bt + (size_t)nxt.pn * tstepB : cB;
        for (int t = 0; t < nt; t += 2) {
            const bool last = (t == nt - 2);
            const char* a1 = cA + (size_t)(t + 1) * kstep;
            const char* a2 = last ? nA : cA + (size_t)(t + 2) * kstep; const char* b2 = last ? nB : cB + (size_t)(t + 2) * kstep;
            const char* a3 = a2 + kstep; const char* b3 = b2 + kstep;
            if (last && has_next) S.a_ready(nxt);
            if constexpr (SP2) {
            PG8_LDB(B0, 0, 0); PG8_LDB(B1, 0, 1); PG8_SCHED; PG8_LDA(At, 0, 0); PG8_STAGE(PG8_SA(1, 1), a1 + hstepA, voffA);
            PG8_WAIT_V(8); PG8_WAIT_L(0); PG8_BAR; PG8_MMA(0, 0, At, B0); PG8_MMA(0, 1, At, B1); PG8_BAR; PG8_SCHED;
            PG8_LDA(At, 0, 1); PG8_STAGE(PG8_SB(0, 0), b2, voffB); PG8_STAGE(PG8_SB(0, 1), b2 + hstepB, voffB); PG8_STAGE(PG8_SA(0, 0), a2, voffA);
            PG8_WAIT_V(8); PG8_WAIT_L(0); PG8_BAR; PG8_MMA(1, 0, At, B0); PG8_MMA(1, 1, At, B1); PG8_BAR; PG8_SCHED;
            PG8_LDB(B0, 1, 0); PG8_LDB(B1, 1, 1); PG8_SCHED; PG8_LDA(At, 1, 0); PG8_STAGE(PG8_SA(0, 1), a2 + hstepA, voffA);
            PG8_WAIT_V(8); PG8_WAIT_L(0); PG8_BAR; PG8_MMA(0, 0, At, B0); PG8_MMA(0, 1, At, B1); PG8_BAR; PG8_SCHED;
            PG8_LDA(At, 1, 1); PG8_STAGE(PG8_SB(1, 0), b3, voffB); PG8_STAGE(PG8_SB(1, 1), b3 + hstepB, voffB); PG8_STAGE(PG8_SA(1, 0), a3, voffA);
            PG8_WAIT_V(8); PG8_WAIT_L(0); PG8_BAR; PG8_MMA(1, 0, At, B0); PG8_MMA(1, 1, At, B1); PG8_BAR; PG8_SCHED;
            } else {
            PG8_LDB(B0, 0, 0); PG8_SCHED; PG8_LDA(At, 0, 0); PG8_STAGE(PG8_SA(1, 1), a1 + hstepA, voffA);
            PG8_WAIT_L(8); PG8_BAR; PG8_WAIT_L(0); PG8_MMA(0, 0, At, B0); PG8_BAR; PG8_SCHED;
            PG8_LDB(B1, 0, 1); PG8_STAGE(PG8_SB(0, 0), b2, voffB);
            PG8_BAR; PG8_WAIT_L(0); PG8_MMA(0, 1, At, B1); PG8_BAR;
            PG8_LDA(At, 0, 1); PG8_STAGE(PG8_SA(0, 0), a2, voffA);
            PG8_BAR; PG8_WAIT_L(0); PG8_MMA(1, 0, At, B0); PG8_BAR; PG8_SCHED;
            PG8_STAGE(PG8_SB(0, 1), b2 + hstepB, voffB);
            PG8_WAIT_V(6); PG8_BAR; PG8_MMA(1, 1, At, B1); PG8_BAR;
            PG8_LDB(B0, 1, 0); PG8_SCHED; PG8_LDA(At, 1, 0); PG8_STAGE(PG8_SA(0, 1), a2 + hstepA, voffA);
            PG8_WAIT_L(8); PG8_BAR; PG8_WAIT_L(0); PG8_MMA(0, 0, At, B0); PG8_BAR; PG8_SCHED;
            PG8_LDB(B1, 1, 1); PG8_STAGE(PG8_SB(1, 0), b3, voffB);
            PG8_BAR; PG8_WAIT_L(0); PG8_MMA(0, 1, At, B1); PG8_BAR;
            PG8_LDA(At, 1, 1); PG8_STAGE(PG8_SA(1, 0), a3, voffA);
            PG8_BAR; PG8_WAIT_L(0); PG8_MMA(1, 0, At, B0); PG8_BAR; PG8_SCHED;
            PG8_STAGE(PG8_SB(1, 1), b3 + hstepB, voffB);
            PG8_WAIT_V(6); PG8_BAR; PG8_MMA(1, 1, At, B1); PG8_BAR;
            }
        }
        if constexpr (ALIGN_EPI) { if (wr == 0) PG8_BAR; }
        if constexpr (!Epi::AFTER_DRAIN) { E(acc, cur, wr, wc, fr, fq); S.done(cur); }
        if (!has_next) break;
#pragma unroll
        for (int a = 0; a < 2; ++a)
#pragma unroll
            for (int b = 0; b < 2; ++b)
#pragma unroll
                for (int m = 0; m < 4; ++m)
#pragma unroll
                    for (int n = 0; n < 2; ++n) acc[a][b][m][n] = (f32x4){0.f, 0.f, 0.f, 0.f};
        cur = nxt; cA = nA; cB = nB; ++ui;
        if constexpr (ALIGN_EPI) { if (wr == 1) PG8_BAR; }
    }
    PG8_WAIT_V(0);
    if constexpr (!ALIGN_EPI) { if (wr == 0) PG8_BAR; }
    PG8_BAR;
    if constexpr (Epi::AFTER_DRAIN) { E.fused(acc, cur, wr, wc, fr, fq, lds, wid, lane); S.done(cur); }
#undef PG8_SA
#undef PG8_SB
#undef PG8_STAGE
#undef PG8_LDA
#undef PG8_LDB
#undef PG8_MMA
#undef PG8_WAIT_V
#undef PG8_WAIT_L
#undef PG8_BAR
#undef PG8_SCHED
}
}
namespace att {
using bf16 = unsigned short;
using bf16x8 = __attribute__((ext_vector_type(8))) short;
using s16x4  = __attribute__((ext_vector_type(4))) short;
using f32x16 = __attribute__((ext_vector_type(16))) float;
using u32x4  = __attribute__((ext_vector_type(4))) unsigned;
constexpr int NW = 8, QBLK = 32, KVBLK = 64, DV = 128;
constexpr float THR = 8.f;
constexpr int SHM_V = KVBLK * DV * 2;
constexpr int SHM_KMAX = KVBLK * 192 * 2;
#ifndef ATT_QLDS
#define ATT_QLDS 0
#endif
constexpr int OFF_V = 0, OFF_K = 2 * SHM_V, OFF_WS = OFF_K + 2 * SHM_KMAX, OFF_BIAS = OFF_WS + NW * 64 * 4, OFF_QL = OFF_BIAS + 4096, ATTN_LDS_BYTES = OFF_QL + NW * ATT_QLDS * 1024;
#define SBAR() __builtin_amdgcn_sched_barrier(0)
__device__ __forceinline__ int crow(int r, int hi) { return (r & 3) + 8 * (r >> 2) + 4 * hi; }
__device__ __forceinline__ unsigned cvtpk(float lo, float hi) { unsigned r; asm volatile("v_cvt_pk_bf16_f32 %0, %1, %2" : "=v"(r) : "v"(lo), "v"(hi)); return r; }
__device__ __forceinline__ bf16x8 ld8(const bf16* p) { return *reinterpret_cast<const bf16x8*>(p); }

template <int MODE> struct Cfg {
    static constexpr int DQ = MODE == 0 ? 192 : 128, ND0 = DQ / 16, KPITCH = DQ * 2, SHM_K = KVBLK * KPITCH;
    static constexpr float SCALE = MODE == 0 ? 0.07216878364870322f : 1.0f;
};
constexpr float NA_SCALE = 0.08838834764831845f;

template <int MODE, bool EXP0 = true>
__device__ __forceinline__ void partialSM(f32x16& p0, f32x16& p1, float& m_reg, float& mn, float& alpha) {
  constexpr float SC = Cfg<MODE>::SCALE, C = SC * 1.4426950408889634f;
  float pmax = p0[0];
#pragma unroll
  for (int r = 1; r < 16; ++r) pmax = fmaxf(pmax, p0[r]);
#pragma unroll
  for (int r = 0; r < 16; ++r) pmax = fmaxf(pmax, p1[r]);
  { auto rr = __builtin_amdgcn_permlane32_swap(__float_as_uint(pmax), __float_as_uint(pmax), false, false);
    pmax = fmaxf(__uint_as_float(rr[0]), __uint_as_float(rr[1])); }
  if (__builtin_expect(__all(pmax - m_reg <= THR / SC), 1)) { mn = m_reg; alpha = 1.f; }
  else { mn = fmaxf(m_reg, pmax); alpha = __builtin_amdgcn_exp2f((m_reg - mn) * C); m_reg = mn; }
  float mnC = -mn * C;
#pragma unroll
  for (int r = 0; r < 16; ++r) p0[r] = fmaf(p0[r], C, mnC);
#pragma unroll
  for (int r = 0; r < 16; ++r) p1[r] = fmaf(p1[r], C, mnC);
  if (EXP0) {
#pragma unroll
  for (int r = 0; r < 16; ++r) p0[r] = __builtin_amdgcn_exp2f(p0[r]); }
}
template <bool EXP0 = false>
__device__ __forceinline__ void finishSM(f32x16& p0, f32x16& p1, float alpha, float& l_reg, bf16x8& pa0, bf16x8& pa1, bf16x8& pa2, bf16x8& pa3) {
  if (EXP0) {
#pragma unroll
  for (int r = 0; r < 16; ++r) p0[r] = __builtin_amdgcn_exp2f(p0[r]); }
#pragma unroll
  for (int r = 0; r < 16; ++r) p1[r] = __builtin_amdgcn_exp2f(p1[r]);
  float ps = 0;
#pragma unroll
  for (int r = 0; r < 16; ++r) ps += p0[r];
#pragma unroll
  for (int r = 0; r < 16; ++r) ps += p1[r];
  { auto rr = __builtin_amdgcn_permlane32_swap(__float_as_uint(ps), __float_as_uint(ps), false, false);
    ps = __uint_as_float(rr[0]) + __uint_as_float(rr[1]); }
  l_reg = l_reg * alpha + ps;
#define PK4(P, BASE, OUT) do { unsigned a0 = cvtpk(P[BASE + 0], P[BASE + 1]), a1 = cvtpk(P[BASE + 2], P[BASE + 3]);   \
    unsigned b0 = cvtpk(P[BASE + 4], P[BASE + 5]), b1 = cvtpk(P[BASE + 6], P[BASE + 7]);                              \
    auto r0 = __builtin_amdgcn_permlane32_swap(a0, b0, false, false); auto r1 = __builtin_amdgcn_permlane32_swap(a1, b1, false, false); \
    u32x4 w = {r0[0], r1[0], r0[1], r1[1]}; OUT = *reinterpret_cast<bf16x8*>(&w); } while (0)
  PK4(p0, 0, pa0); PK4(p0, 8, pa1); PK4(p1, 0, pa2); PK4(p1, 8, pa3);
#undef PK4
}
template <int MODE> __device__ __forceinline__ int kswz(int row) { return MODE == 0 ? (((row >> 1) & 7) << 4) : ((row & 15) << 4); }
template <int MODE>
__device__ __forceinline__ void qkt(f32x16& p0, f32x16& p1, const char* Ks, const bf16x8* qr, const char* ql, int r32, int hi) {
  constexpr int NREG = MODE == 0 ? Cfg<MODE>::ND0 - ATT_QLDS : Cfg<MODE>::ND0;
  constexpr int KP = Cfg<MODE>::KPITCH;
  p0 = f32x16{}; p1 = f32x16{};
  const char* kb4[4];
#pragma unroll
  for (int q = 0; q < 4; ++q) kb4[q] = Ks + r32 * KP + ((q * 32 + hi * 16) ^ kswz<MODE>(r32));
#pragma unroll
  for (int d0 = 0; d0 < Cfg<MODE>::ND0; ++d0) {
    const char* ka = MODE == 0 ? kb4[d0 & 3] + (d0 >> 2) * 128 : Ks + r32 * KP + ((d0 * 32 + hi * 16) ^ kswz<MODE>(r32));
    bf16x8 b0 = *reinterpret_cast<const bf16x8*>(ka);
    bf16x8 b1 = *reinterpret_cast<const bf16x8*>(ka + 32 * KP);
    const bf16x8 qv = d0 < NREG ? qr[d0 < NREG ? d0 : 0] : *reinterpret_cast<const bf16x8*>(ql + (d0 - NREG) * 1024);
    p0 = __builtin_amdgcn_mfma_f32_32x32x16_bf16(b0, qv, p0, 0, 0, 0);
    p1 = __builtin_amdgcn_mfma_f32_32x32x16_bf16(b1, qv, p1, 0, 0, 0); }
}
__device__ __forceinline__ int v_st(int k, int c) { const int kk = (k & ~0xC) | ((k & 4) << 1) | ((k & 8) >> 1); return ((kk >> 3) * 4 + (c >> 5)) * 512 + ((kk & 7) * 32 + (c & 31)) * 2; }
__device__ __forceinline__ int v_rd_base(int lane) { return ((lane & 3) << 3) | (((lane >> 2) & 3) << 6) | (((lane >> 4) & 1) << 5) | (((lane >> 5) & 1) << 8); }
constexpr int v_rd_off(int d0, int ks, int half) { return d0 * 512 + ks * 4096 + half * 2048; }
template <int OFF> __device__ __forceinline__ s16x4 tr_read(int vb) {
  s16x4 r; asm volatile("ds_read_b64_tr_b16 %0, %1 offset:%2" : "=&v"(r) : "v"(vb), "i"(OFF) : "memory"); return r;
}
template <int D0> __device__ __forceinline__ void pv_one(f32x16& od, int vb, bf16x8 pa0, bf16x8 pa1, bf16x8 pa2, bf16x8 pa3) {
  const s16x4 l0 = tr_read<v_rd_off(D0, 0, 0)>(vb), h0 = tr_read<v_rd_off(D0, 0, 1)>(vb), l1 = tr_read<v_rd_off(D0, 1, 0)>(vb), h1 = tr_read<v_rd_off(D0, 1, 1)>(vb);
  const s16x4 l2 = tr_read<v_rd_off(D0, 2, 0)>(vb), h2 = tr_read<v_rd_off(D0, 2, 1)>(vb), l3 = tr_read<v_rd_off(D0, 3, 0)>(vb), h3 = tr_read<v_rd_off(D0, 3, 1)>(vb);
  asm volatile("s_waitcnt lgkmcnt(0)" ::: "memory"); SBAR();
#define PK(L, H) (bf16x8){L[0], L[1], L[2], L[3], H[0], H[1], H[2], H[3]}
  od = __builtin_amdgcn_mfma_f32_32x32x16_bf16(pa0, PK(l0, h0), od, 0, 0, 0);
  od = __builtin_amdgcn_mfma_f32_32x32x16_bf16(pa1, PK(l1, h1), od, 0, 0, 0);
  od = __builtin_amdgcn_mfma_f32_32x32x16_bf16(pa2, PK(l2, h2), od, 0, 0, 0);
  od = __builtin_amdgcn_mfma_f32_32x32x16_bf16(pa3, PK(l3, h3), od, 0, 0, 0);
#undef PK
}
__device__ __forceinline__ void pv_d0(f32x16* o, int vb, bf16x8 pa0, bf16x8 pa1, bf16x8 pa2, bf16x8 pa3) {
  pv_one<0>(o[0], vb, pa0, pa1, pa2, pa3); pv_one<1>(o[1], vb, pa0, pa1, pa2, pa3); pv_one<2>(o[2], vb, pa0, pa1, pa2, pa3); pv_one<3>(o[3], vb, pa0, pa1, pa2, pa3);
}
__device__ __forceinline__ void na_mask(f32x16& p0, f32x16& p1, const float* bias  , int krow, int rq, int rs, int cq, int cs, int hi) {
  const bool rowok = (krow >= rs) && (krow <= rs + 7);
  int drow = krow - rq + 7; drow = drow < 0 ? 0 : (drow > 14 ? 14 : drow);
  const float* bt = bias + 64 + drow * 31 + (15 - cq + 4 * hi);
  const int kb = 4 * hi - cs;
#pragma unroll
  for (int r = 0; r < 16; ++r) { const int cr = (r & 3) + 8 * (r >> 2);
    const bool ok0 = rowok && (unsigned)(kb + cr) < 16u, ok1 = rowok && (unsigned)(kb + cr + 32) < 16u;
    const float b0 = bt[cr], b1 = bt[cr + 32];
    p0[r] = ok0 ? fmaf(p0[r], NA_SCALE, b0) : -INFINITY;
    p1[r] = ok1 ? fmaf(p1[r], NA_SCALE, b1) : -INFINITY; }
}

template <int MODE>
__device__ __forceinline__ void attn_unit(const bf16* __restrict__ Qb, int LDQ, const bf16* __restrict__ Kn, const bf16* __restrict__ Kr, const bf16* __restrict__ Vh, int LDK,
                                          bf16* __restrict__ Ob, int LDO, int kt0, int NT, char* lds, int r0, const float* __restrict__ rpb) {
  constexpr int ND0 = Cfg<MODE>::ND0, KP = Cfg<MODE>::KPITCH, SHM_K = Cfg<MODE>::SHM_K;
  const int tid = threadIdx.x, wid = tid >> 6, lane = tid & 63, r32 = lane & 31, hi = lane >> 5;
  char* V_lds = lds + OFF_V; char* K_lds = lds + OFF_K;
  float* ws = (float*)(lds + OFF_WS) + wid * 64; float* li_l = ws; float* al_l = ws + 32;
  float* bias_l = (float*)(lds + OFF_BIAS);
  constexpr int NQR = MODE == 0 ? ND0 - ATT_QLDS : ND0;
  float m_reg = -1e30f, l_reg = 0; f32x16 o[4] = {}; bf16x8 qr[NQR > 0 ? NQR : 1];
  const bf16* Qw = Qb + (long)(wid * QBLK + r32) * LDQ + hi * 8;
  char* ql = lds + OFF_QL + wid * (ATT_QLDS * 1024) + lane * 16;
#pragma unroll
  for (int d0 = 0; d0 < ND0; ++d0) { if (d0 < NQR) qr[d0 < NQR ? d0 : 0] = ld8(Qw + d0 * 16); else *reinterpret_cast<bf16x8*>(ql + (d0 - NQR) * 1024) = ld8(Qw + d0 * 16); }
  int rq = 0, rs = 0, cq = 0, cs = 0;
  if (MODE == 1) { rq = r0 + (wid >> 1); rs = rq - 4; rs = rs < 0 ? 0 : (rs > 120 ? 120 : rs); cq = (wid & 1) * 32 + r32; cs = cq - 8; cs = cs < 0 ? 0 : (cs > 48 ? 48 : cs);
    for (int i = tid; i < 15 * 31; i += 512) bias_l[64 + i] = rpb[i]; }
  const int sr = tid >> 4, sc = (tid & 15) * 8, vst0 = v_st(sr, sc), vst1 = v_st(32 + sr, sc);
  const int rr = tid >> 3, rc = (tid & 7) * 8;
  const int vb0 = (int)(uintptr_t)V_lds + v_rd_base(lane);
  const long k0g = (long)kt0 * KVBLK;
#ifndef ATT_SD
#define ATT_SD 1
#endif
#ifndef ATT_SIMPLE0
#define ATT_SIMPLE0 2
#endif
  struct { bf16x8 vs0, vs1, ks0, ks1, kr0; } sr_[ATT_SD];
  const int voff = sr * LDK + sc, kroff = rr * 64 + rc;
#define SLOAD(i, kk) do { const long _k = k0g + (kk); const bf16* _v = Vh + _k * LDK; const bf16* _n = Kn + _k * LDK; \
    sr_[i].vs0 = ld8(_v + voff); sr_[i].vs1 = ld8(_v + 32 * LDK + voff); sr_[i].ks0 = ld8(_n + voff); sr_[i].ks1 = ld8(_n + 32 * LDK + voff); \
    if (MODE == 0) sr_[i].kr0 = ld8(Kr + _k * 64 + kroff); } while (0)
#define SWRITE(b, i) do { *(bf16x8*)(V_lds + (b) * SHM_V + vst0) = sr_[i].vs0;          \
    *(bf16x8*)(V_lds + (b) * SHM_V + vst1) = sr_[i].vs1; const int kc = sc * 2;               \
    *(bf16x8*)(K_lds + (b) * SHM_K + sr * KP + (kc ^ kswz<MODE>(sr))) = sr_[i].ks0;                       \
    *(bf16x8*)(K_lds + (b) * SHM_K + (32 + sr) * KP + (kc ^ kswz<MODE>(sr))) = sr_[i].ks1;            \
    if (MODE == 0) *(bf16x8*)(K_lds + (b) * SHM_K + rr * KP + ((256 + rc * 2) ^ kswz<MODE>(rr))) = sr_[i].kr0; } while (0)
#define SWAIT() do { if (ATT_SD == 1) asm volatile("s_waitcnt vmcnt(0)" ::: "memory"); else if (MODE == 0) asm volatile("s_waitcnt vmcnt(5)" ::: "memory"); else asm volatile("s_waitcnt vmcnt(4)" ::: "memory"); } while (0)
#define RESC(a) do { if (__any((a) < 1.f)) { if (hi == 0) al_l[r32] = (a); asm volatile("s_waitcnt lgkmcnt(0)" ::: "memory"); \
    _Pragma("unroll") for (int d = 0; d < 4; ++d) _Pragma("unroll") for (int r = 0; r < 16; ++r) o[d][r] *= al_l[crow(r, hi)]; } } while (0)
#define MASK(P0, P1, j) do { if (MODE == 1) na_mask(P0, P1, bias_l, kt0 + (j), rq, rs, cq, cs, hi); } while (0)
  bf16x8 pa0, pa1, pa2, pa3;
  if constexpr (MODE == 0 && ATT_SIMPLE0 == 2) {
    f32x16 pA0, pA1; float mnA, alA = 1.f; const int grp = wid >> 2;
    SLOAD(0, 0); asm volatile("s_waitcnt vmcnt(0)" ::: "memory"); _Pragma("unroll") for (int d0 = 0; d0 < NQR; ++d0) asm volatile("" : "+v"(qr[d0]));     SWRITE(0, 0); __syncthreads();
    for (int s = 0; s <= 2 * NT; ++s) {
      const int sl = s - grp, jn = (s >> 1) + 1;
      if (!(s & 1) && jn < NT) SLOAD(0, jn * KVBLK);
      if (sl >= 0 && sl < 2 * NT) { const int j = sl >> 1, b = j & 1;
        if (!(sl & 1)) { SBAR(); qkt<MODE>(pA0, pA1, K_lds + b * SHM_K, qr, ql, r32, hi); partialSM<MODE, false>(pA0, pA1, m_reg, mnA, alA); SBAR(); }
        else { RESC(alA); finishSM<true>(pA0, pA1, alA, l_reg, pa0, pa1, pa2, pa3); SBAR(); pv_d0(o, vb0 + b * SHM_V, pa0, pa1, pa2, pa3); SBAR(); } }
      if ((s & 1) && jn < NT) SWRITE(jn & 1, 0);
      asm volatile("s_waitcnt lgkmcnt(0)\n\ts_barrier" ::: "memory");
    }
    __syncthreads();
  } else if constexpr (MODE == 0 && ATT_SIMPLE0) {
    f32x16 pA0, pA1; float mnA, alA;
    SLOAD(0, 0); asm volatile("s_waitcnt vmcnt(0)" ::: "memory"); _Pragma("unroll") for (int d0 = 0; d0 < NQR; ++d0) asm volatile("" : "+v"(qr[d0]));     SWRITE(0, 0); __syncthreads();
    for (int j = 0; j < NT; ++j) {
      const int b = j & 1;
      if (j + 1 < NT) SLOAD(0, (j + 1) * KVBLK);
      SBAR(); qkt<MODE>(pA0, pA1, K_lds + b * SHM_K, qr, ql, r32, hi); MASK(pA0, pA1, j);
      partialSM<MODE>(pA0, pA1, m_reg, mnA, alA); RESC(alA);
      finishSM(pA0, pA1, alA, l_reg, pa0, pa1, pa2, pa3); SBAR();
      pv_d0(o, vb0 + b * SHM_V, pa0, pa1, pa2, pa3); SBAR();
      if (j + 1 < NT) SWRITE(b ^ 1, 0);
      __syncthreads();
    }
  } else {
  f32x16 pA0, pA1, pB0, pB1; float mnA, mnB, alA, alB; bf16x8 pa0, pa1, pa2, pa3;
  constexpr int SE = 0, SO = ATT_SD - 1;
  SLOAD(SE, 0); asm volatile("s_waitcnt vmcnt(0)" ::: "memory"); _Pragma("unroll") for (int d0 = 0; d0 < NQR; ++d0) asm volatile("" : "+v"(qr[d0]));     SWRITE(0, SE); __syncthreads();
  qkt<MODE>(pA0, pA1, K_lds, qr, ql, r32, hi); MASK(pA0, pA1, 0); partialSM<MODE>(pA0, pA1, m_reg, mnA, alA);
  SLOAD(SO, KVBLK); if (ATT_SD == 2) { if (2 < NT) SLOAD(SE, 2 * KVBLK); }
  SWAIT(); SWRITE(1, SO); __syncthreads();
  for (int j = 1; j + 1 < NT; j += 2) {
    SBAR(); qkt<MODE>(pB0, pB1, K_lds + SHM_K, qr, ql, r32, hi); MASK(pB0, pB1, j);
    finishSM(pA0, pA1, alA, l_reg, pa0, pa1, pa2, pa3); SBAR();
    SLOAD(SO, (j + ATT_SD) * KVBLK); SBAR();
    pv_d0(o, vb0, pa0, pa1, pa2, pa3); partialSM<MODE>(pB0, pB1, m_reg, mnB, alB);
    __syncthreads(); SWAIT(); SWRITE(0, SE);
    RESC(alB); __syncthreads();
    SBAR(); qkt<MODE>(pA0, pA1, K_lds, qr, ql, r32, hi); MASK(pA0, pA1, j + 1);
    finishSM(pB0, pB1, alB, l_reg, pa0, pa1, pa2, pa3); SBAR();
    if (ATT_SD == 1 || j + 3 < NT) SLOAD(SE, (j + 1 + ATT_SD) * KVBLK); SBAR();
    pv_d0(o, vb0 + SHM_V, pa0, pa1, pa2, pa3); partialSM<MODE>(pA0, pA1, m_reg, mnA, alA);
    __syncthreads(); SWAIT(); SWRITE(1, SO);
    RESC(alA); __syncthreads();
  }
  SBAR(); qkt<MODE>(pB0, pB1, K_lds + SHM_K, qr, ql, r32, hi); MASK(pB0, pB1, NT - 1);
  finishSM(pA0, pA1, alA, l_reg, pa0, pa1, pa2, pa3); SBAR();
  pv_d0(o, vb0, pa0, pa1, pa2, pa3); partialSM<MODE>(pB0, pB1, m_reg, mnB, alB);
  __syncthreads(); RESC(alB);
  finishSM(pB0, pB1, alB, l_reg, pa0, pa1, pa2, pa3); SBAR();
  pv_d0(o, vb0 + SHM_V, pa0, pa1, pa2, pa3);
  }
  if (hi == 0) li_l[r32] = l_reg; asm volatile("s_waitcnt lgkmcnt(0)" ::: "memory");
  float rli[16];
#pragma unroll
  for (int r = 0; r < 16; ++r) rli[r] = __builtin_amdgcn_rcpf(li_l[crow(r, hi)]);
  bf16* Ow = Ob + (long)(wid * QBLK) * LDO;
#pragma unroll
  for (int r = 0; r < 16; ++r) { const int orow = crow(r, hi);
#pragma unroll
    for (int d0 = 0; d0 < 4; ++d0) { const float v = o[d0][r] * rli[r]; Ow[(long)orow * LDO + d0 * 32 + r32] = (bf16)(cvtpk(v, v) & 0xffffu); } }
  __syncthreads();
#undef SLOAD
#undef SWRITE
#undef SWAIT
#undef RESC
#undef MASK
}
#undef SBAR
}

constexpr int NWAVES = 8;
constexpr int S = 8192, DM = 2048, INC = 3904, ZLD = 4096, DFF = 8192;
constexpr size_t MiB = 1u << 20;
constexpr size_t WS_CS = 0;
constexpr size_t WS_SSQ1 = 2 * MiB;
constexpr size_t WS_SSQ2 = WS_SSQ1 + 512 * 1024;
constexpr size_t WS_SSQ3 = WS_SSQ2 + 512 * 1024;
constexpr size_t WS_BAR = 3 * MiB + 512 * 1024;
constexpr size_t WS_WIN = 4 * MiB;
constexpr size_t WS_WUQ = 20 * MiB;
constexpr size_t WS_WUKV = 22 * MiB;
constexpr size_t WS_WOUT = 23 * MiB;
constexpr size_t WS_W1 = 31 * MiB;
constexpr size_t WS_W2 = 63 * MiB;
constexpr size_t WS_Z = 96 * MiB;
constexpr size_t WS_H = 160 * MiB;
constexpr size_t WS_Q = 160 * MiB;
constexpr size_t WS_KR = 184 * MiB;
constexpr size_t WS_KV = 192 * MiB;
constexpr size_t WS_MIX = 224 * MiB;
constexpr size_t WS_X1B = 96 * MiB;
constexpr size_t WS_U = 128 * MiB;
constexpr size_t WS_END = 256 * MiB;
constexpr int LDS_BYTES = 147456;
static_assert(att::ATTN_LDS_BYTES <= LDS_BYTES, "attention LDS");

#define GAS __attribute__((address_space(1)))
#define LAS __attribute__((address_space(3)))
typedef unsigned short bf16;
typedef unsigned v4u __attribute__((ext_vector_type(4)));
typedef float f32x4 __attribute__((ext_vector_type(4)));
typedef short bf16x8 __attribute__((ext_vector_type(8)));
#define LDS_WAIT() asm volatile("s_waitcnt lgkmcnt(0)" ::: "memory")
__device__ __forceinline__ unsigned f2bf(float f) { unsigned u = __builtin_bit_cast(unsigned, f); return (u + 0x7fffu + ((u >> 16) & 1u)) >> 16; }
__device__ __forceinline__ unsigned pk2(float lo, float hi) { return f2bf(lo) | (f2bf(hi) << 16); }
__device__ __forceinline__ float bf2f(unsigned short b) { return __builtin_bit_cast(float, (unsigned)b << 16); }
__device__ __forceinline__ float wave_sum(float v) {
#pragma unroll
    for (int o = 1; o < 64; o <<= 1) v += __shfl_xor(v, o);
    return v;
}
__device__ const float ROPE_INV[32] = {1.000000000e+00f, 7.498942614e-01f, 5.623413324e-01f, 4.216965139e-01f, 3.162277639e-01f, 2.371373773e-01f, 1.778279394e-01f, 1.333521307e-01f, 1.000000015e-01f, 7.498941571e-02f, 5.623413250e-02f, 4.216965288e-02f, 3.162277490e-02f, 2.371373773e-02f, 1.778279431e-02f, 1.333521493e-02f, 9.999999776e-03f, 7.498941850e-03f, 5.623413250e-03f, 4.216964822e-03f, 3.162277630e-03f, 2.371373586e-03f, 1.778279431e-03f, 1.333521446e-03f, 1.000000047e-03f, 7.498942432e-04f, 5.623413017e-04f, 4.216965172e-04f, 3.162277571e-04f, 2.371373703e-04f, 1.778279402e-04f, 1.333521504e-04f};
__device__ __forceinline__ void rope_cs(int pos, int i, float& c, float& s) {
    const float ang = (float)pos * ROPE_INV[i];
    const double t = (double)ang * 0.15915494309189535; const float fr = (float)(t - rint(t));
    s = __builtin_amdgcn_sinf(fr); c = __builtin_amdgcn_cosf(fr);
}

__device__ __forceinline__ int uq_perm(int n) { const int h = n / 192, d = n - h * 192; if (d < 128) return h * 128 + d; const int i = d - 128; return 1024 + h * 64 + ((i & 31) << 1) + (i >> 5); }
template <bool PERMQ>
__device__ __forceinline__ void p0_transpose_item(const float* __restrict__ W, const float* __restrict__ g, int K, int N, bf16* __restrict__ WT, LAS float* scr, int item, int lane) {
    const int nblk = N / 32, kb = item / nblk, nb = item % nblk, k0 = 64 * kb, n0 = 32 * nb;
    float wv[32];
#pragma unroll
    for (int i = 0; i < 32; ++i) { const int kk = 2 * i + (lane >> 5); wv[i] = W[(size_t)(k0 + kk) * N + n0 + (lane & 31)]; }
    if (g) {
#pragma unroll
        for (int i = 0; i < 32; ++i) wv[i] *= g[k0 + 2 * i + (lane >> 5)]; }
#pragma unroll
    for (int i = 0; i < 32; ++i) scr[(2 * i + (lane >> 5)) * 33 + (lane & 31)] = wv[i];
    LDS_WAIT(); asm volatile("" ::: "memory");
    const int c = lane & 7;
#pragma unroll
    for (int j = 0; j < 4; ++j) { const int n = (lane >> 3) + 8 * j; const LAS float* s = scr + (8 * c) * 33 + n;
        v4u o; o.x = pk2(s[0 * 33], s[1 * 33]); o.y = pk2(s[2 * 33], s[3 * 33]); o.z = pk2(s[4 * 33], s[5 * 33]); o.w = pk2(s[6 * 33], s[7 * 33]);
        const int dn = PERMQ ? uq_perm(n0 + n) : (n0 + n);
        *(v4u*)(WT + (size_t)dn * K + k0 + 8 * c) = o; }
    LDS_WAIT(); asm volatile("" ::: "memory");
}
__device__ __forceinline__ void rms_row_to_bf16(const float* __restrict__ xrow, const float* __restrict__ g, bf16* __restrict__ orow, int lane) {
    const f32x4* xr = (const f32x4*)xrow + lane; const f32x4* gr = (const f32x4*)g + lane;
    f32x4 v[8]; float s = 0.f;
#pragma unroll
    for (int j = 0; j < 8; ++j) { v[j] = xr[64 * j]; s += pg8::dot4(v[j]); }
    const float rstd = 1.0f / sqrtf(wave_sum(s) * (1.f / 2048.f) + pg8::NORM_EPS);
    unsigned long long* o8 = (unsigned long long*)orow + lane;
#pragma unroll
    for (int j = 0; j < 8; ++j) { const f32x4 gg = gr[64 * j]; o8[64 * j] = (unsigned long long)pk2(v[j][0] * rstd * gg[0], v[j][1] * rstd * gg[1]) | ((unsigned long long)pk2(v[j][2] * rstd * gg[2], v[j][3] * rstd * gg[3]) << 32); }
}

#define XB_TMO      128
#define XB_XCNT(j)  (256  + 64 * (j))
#define XB_XSUB(j)  (1280 + 64 * (j))
#define XB_XGEN(j)  (2304 + 64 * (j))
#define XB_TOP      3328
#define XB_TOPGEN   3392
#define XCD_BAR_WORDS 3456
#define XB_SPIN_CAP (1u << 18)

__device__ __forceinline__ unsigned xb_ld(unsigned* p)              { return __hip_atomic_load(p, __ATOMIC_RELAXED, __HIP_MEMORY_SCOPE_AGENT); }
__device__ __forceinline__ unsigned xb_add(unsigned* p, unsigned v) { return __hip_atomic_fetch_add(p, v, __ATOMIC_RELAXED, __HIP_MEMORY_SCOPE_AGENT); }
__device__ __forceinline__ unsigned xb_xcc_id() { return (unsigned)__builtin_amdgcn_s_getreg((3 << 11) | 20) & 0xFu; }
#define XB_SPIN(cond, bar) do { unsigned _sp = 0; while (cond) { __builtin_amdgcn_s_sleep(1); \
    if ((++_sp & 255u) == 0u) { if (xb_ld(&(bar)[XB_TMO])) break; if (_sp > XB_SPIN_CAP) { atomicAdd(&(bar)[XB_TMO], 1u); break; } } } } while (0)

struct XcdBarrier {
    unsigned* bar; unsigned x;
    volatile LAS unsigned* st;
};

__device__ __forceinline__ XcdBarrier xcd_barrier_post(unsigned* bar, volatile LAS unsigned* st) {
    XcdBarrier b; b.bar = bar; b.x = xb_xcc_id(); b.st = st;
    if (threadIdx.x == 0) (void)xb_add(&bar[XB_XCNT(b.x)], 1u);
    return b;
}
__device__ __forceinline__ void xcd_barrier_complete(unsigned* bar, unsigned x, unsigned& nloc, unsigned& nx) {
    const unsigned G = gridDim.x * gridDim.y * gridDim.z;
    unsigned sum, cnt, mine, sp = 0u;
    for (;;) {
        sum = 0u; cnt = 0u; mine = 0u;
#pragma unroll
        for (unsigned j = 0; j < 16; ++j) { const unsigned c = xb_ld(&bar[XB_XCNT(j)]); sum += c; cnt += (c > 0u) ? 1u : 0u; mine = (j == x) ? c : mine; }
        if (sum == G) break;
        __builtin_amdgcn_s_sleep(1);
        if ((++sp & 255u) == 0u) { if (xb_ld(&bar[XB_TMO])) break; if (sp > XB_SPIN_CAP) { atomicAdd(&bar[XB_TMO], 1u); break; } }
    }
    nloc = mine > 0u ? mine : 1u; nx = cnt > 0u ? cnt : 1u;
}

__device__ __forceinline__ void xcd_barrier(const XcdBarrier& b) {
    asm volatile("s_waitcnt vmcnt(0)" ::: "memory");
    __syncthreads();
    if (threadIdx.x == 0) {
        unsigned* bar = b.bar;
        __builtin_amdgcn_s_waitcnt(0);
        unsigned nloc = b.st[0], nx = b.st[1];
        if (nloc == 0u) { xcd_barrier_complete(bar, b.x, nloc, nx); b.st[0] = nloc; b.st[1] = nx; }
        const unsigned old = xb_add(&bar[XB_XSUB(b.x)], 1u);
        const unsigned gen = old / nloc;
        if (old + 1u == (gen + 1u) * nloc) {
            __builtin_amdgcn_fence(__ATOMIC_RELEASE, "agent");
            asm volatile("s_waitcnt vmcnt(0)" ::: "memory");
            const unsigned og = xb_add(&bar[XB_TOP], 1u);
            const unsigned tg = og / nx;
            if (og + 1u == (tg + 1u) * nx) xb_add(&bar[XB_TOPGEN], 1u);
            else XB_SPIN(xb_ld(&bar[XB_TOPGEN]) == tg, bar);
            __builtin_amdgcn_fence(__ATOMIC_ACQUIRE, "agent");
            xb_add(&bar[XB_XGEN(b.x)], 1u);
            asm volatile("s_waitcnt vmcnt(0)" ::: "memory");
        } else {
            XB_SPIN(xb_ld(&bar[XB_XGEN(b.x)]) == gen, bar);
            __builtin_amdgcn_fence(__ATOMIC_ACQUIRE, "agent");
            asm volatile("s_waitcnt vmcnt(0)" ::: "memory");
        }
    }
    __syncthreads();
}

struct Args { const float* in[15]; float* out; unsigned char* ws; int ph_lo, ph_hi; };
constexpr int N_PHASES = 9;

__global__ void __launch_bounds__(NWAVES * 64, 2) mk_fwd(Args args) {
    extern __shared__ __attribute__((aligned(16))) unsigned char lds[];
    cg::grid_group grid = cg::this_grid();
    const int tid = threadIdx.x, lane = tid & 63, wave = __builtin_amdgcn_readfirstlane(tid >> 6);
    const int G = gridDim.x, bx = blockIdx.x;
    unsigned char* ws = args.ws;
    const float* x = args.in[0]; const float* attn_g = args.in[1]; const float* w_in = args.in[2]; const float* qn_g = args.in[3]; const float* w_uq = args.in[4];
    const float* kvn_g = args.in[5]; const float* w_ukv = args.in[6]; const float* rpb = args.in[7]; const float* mla_g = args.in[8]; const float* na_g = args.in[9];
    const float* w_out = args.in[10]; const float* mlp_g = args.in[11]; const float* w_ff1 = args.in[12]; const float* w_ff2 = args.in[13]; const float* fin_g = args.in[14];
    float* out = args.out;
    float* CS = (float*)(ws + WS_CS); float* SSQ1 = (float*)(ws + WS_SSQ1); float* SSQ2 = (float*)(ws + WS_SSQ2); float* SSQ3 = (float*)(ws + WS_SSQ3);
    bf16* WIN = (bf16*)(ws + WS_WIN); bf16* WUQ = (bf16*)(ws + WS_WUQ); bf16* WUKV = (bf16*)(ws + WS_WUKV); bf16* WOUT = (bf16*)(ws + WS_WOUT); bf16* W1 = (bf16*)(ws + WS_W1); bf16* W2 = (bf16*)(ws + WS_W2);
    bf16* Z = (bf16*)(ws + WS_Z); bf16* H = (bf16*)(ws + WS_H); bf16* Q = (bf16*)(ws + WS_Q); bf16* KR = (bf16*)(ws + WS_KR); bf16* KV = (bf16*)(ws + WS_KV);
    bf16* MIX = (bf16*)(ws + WS_MIX); bf16* X1B = (bf16*)(ws + WS_X1B); bf16* U = (bf16*)(ws + WS_U);
    const int lo = args.ph_lo, hi = args.ph_hi;
#ifndef PH_MASK
#define PH_MASK 0x1ff
#endif
#ifndef REP_MASK
#define REP_MASK 0
#endif
#ifndef EXTRA_SYNC
#define EXTRA_SYNC 0
#endif
#ifndef USE_XCDBAR
#define USE_XCDBAR 1
#endif
#define IN(k) ((((PH_MASK) >> (k)) & 1) && lo <= (k) && (k) < hi)
#define GBAR() do { if (USE_XCDBAR && xb_ready) xcd_barrier(xbar); else { grid.sync(); if (USE_XCDBAR) { xbar = xcd_barrier_post(barw, (volatile LAS unsigned*)(ldsp + 131072 + 512)); xb_ready = true; } } } while (0)
#define SEAM(k) do { if (IN(k) && IN((k) + 1)) { GBAR(); for (int xs_ = 0; xs_ < EXTRA_SYNC; ++xs_) GBAR(); } } while (0)
#define NREP(k) ((((REP_MASK) >> (k)) & 1) ? 2 : 1)
    const int gw = bx * NWAVES + wave, NGW = G * NWAVES;
    PG8_LAS unsigned char* ldsp = (PG8_LAS unsigned char*)lds;
    unsigned* barw = (unsigned*)(ws + WS_BAR); XcdBarrier xbar; xbar.bar = barw; xbar.x = 0; xbar.st = nullptr; bool xb_ready = false;
    if (USE_XCDBAR) {
        if (tid < 2) ((volatile LAS unsigned*)(ldsp + 131072 + 512))[tid] = 0u;
        if (bx == 0) for (int i = tid; i < XCD_BAR_WORDS; i += NWAVES * 64) __hip_atomic_store(barw + i, 0u, __ATOMIC_RELAXED, __HIP_MEMORY_SCOPE_AGENT);
        __syncthreads();
    }

    if (IN(0)) for (int rep_ = 0; rep_ < NREP(0); ++rep_) { if (rep_) GBAR();
        LAS float* scr = (LAS float*)(ldsp + wave * 16384);
        constexpr int I_IN = (DM / 64) * (INC / 32), I_UQ = (512 / 64) * (1536 / 32), I_UKV = (256 / 64) * (2048 / 32), I_OUT = (DM / 64) * (DM / 32), I_1 = (DM / 64) * (DFF / 32), I_2 = (DFF / 64) * (DM / 32);
        constexpr int NITEMS = I_IN + I_UQ + I_UKV + I_OUT + I_1 + I_2;
        for (int it = gw; it < NITEMS; it += NGW) {
            int r = it;
            if (r < I_IN) { p0_transpose_item<false>(w_in, nullptr, DM, INC, WIN, scr, r, lane); continue; } r -= I_IN;
            if (r < I_UQ) { p0_transpose_item<true>(w_uq, qn_g, 512, 1536, WUQ, scr, r, lane); continue; } r -= I_UQ;
            if (r < I_UKV) { p0_transpose_item<false>(w_ukv, kvn_g, 256, 2048, WUKV, scr, r, lane); continue; } r -= I_UKV;
            if (r < I_OUT) { p0_transpose_item<false>(w_out, nullptr, DM, DM, WOUT, scr, r, lane); continue; } r -= I_OUT;
            if (r < I_1) { p0_transpose_item<false>(w_ff1, mlp_g, DM, DFF, W1, scr, r, lane); continue; } r -= I_1;
            p0_transpose_item<false>(w_ff2, nullptr, DFF, DM, W2, scr, r, lane);
        }
        for (int i = bx * 512 + tid; i < 192 * 2048 / 8; i += G * 512) ((v4u*)(WIN + (size_t)INC * DM))[i] = (v4u){0u, 0u, 0u, 0u};
        for (int m = gw; m < S; m += NGW) rms_row_to_bf16(x + (size_t)m * DM, attn_g, H + (size_t)m * DM, lane);
        for (int e = bx * 512 + tid; e < S * 32; e += G * 512) { float c, s; rope_cs(e >> 5, e & 31, c, s); CS[2 * e] = c; CS[2 * e + 1] = s; }
    }
    SEAM(0);
    if (IN(1)) for (int rep_ = 0; rep_ < NREP(1); ++rep_) { if (rep_) GBAR();
        pg8::Gemm g{H, WIN, S, ZLD, DM, DM, DM}; pg8::StaticOrder So; So.init(S, ZLD, G, bx);
        pg8::EpiZ E{Z, SSQ1};
        pg8::gemm_phase<pg8::EpiZ, pg8::StaticOrder, true, true>(ldsp, g, So, E);
    }
    SEAM(1);
    if (IN(2)) for (int rep_ = 0; rep_ < NREP(2); ++rep_) { if (rep_) GBAR();
        { pg8::Gemm g{Z, WUQ, S, 1536, 512, ZLD, 512}; pg8::StaticOrder So; So.init(S, 1536, G, bx);
          pg8::EpiQ E{Q, SSQ1, CS};
          pg8::gemm_phase<pg8::EpiQ, pg8::StaticOrder, true, true>(ldsp, g, So, E); }
        { pg8::Gemm g{Z + 512, WUKV, S, 2048, 256, ZLD, 256}; pg8::StaticOrder So; So.init(S, 2048, G, bx);
          pg8::EpiKV E{KV, SSQ1};
          pg8::gemm_phase<pg8::EpiKV, pg8::StaticOrder, true, true>(ldsp, g, So, E); }
        for (int e = bx * 512 + tid; e < S * 32; e += G * 512) { const int pos = e >> 5, i = e & 31;
            const float x1 = bf2f(Z[(size_t)pos * ZLD + 768 + i]), x2 = bf2f(Z[(size_t)pos * ZLD + 800 + i]); const float c = CS[2 * e], s = CS[2 * e + 1];
            ((unsigned*)KR)[e] = pk2(x1 * c - x2 * s, x1 * s + x2 * c); }
    }
    SEAM(2);
    if (IN(3)) for (int rep_ = 0; rep_ < NREP(3); ++rep_) { if (rep_) GBAR();
#ifndef ATT_MASK
#define ATT_MASK 3
#endif
        if (ATT_MASK & 1) for (int u = bx; u < 256; u += G) { const int h = u & 7, qb = u >> 3;
            att::attn_unit<0>(Q + (size_t)qb * 256 * 1536 + h * 192, 1536, KV + h * 256, KR, KV + h * 256 + 128, 2048, MIX + (size_t)qb * 256 * 2048 + h * 128, 2048, 0, S / 64, (char*)lds, 0, nullptr); }
        if (ATT_MASK & 2) for (int u = bx; u < 256; u += G) { const int h = u & 7, qb = u >> 3, r0 = 4 * qb;
            int t0 = r0 - 4; t0 = t0 < 0 ? 0 : (t0 > 120 ? 120 : t0); int t1 = r0 + 3 - 4; t1 = (t1 < 0 ? 0 : (t1 > 120 ? 120 : t1)) + 7; int nt = t1 - t0 + 1; if (nt & 1) ++nt;
            att::attn_unit<1>(Z + (size_t)qb * 256 * ZLD + 832 + h * 128, ZLD, Z + 1856 + h * 128, nullptr, Z + 2880 + h * 128, ZLD, MIX + (size_t)qb * 256 * 2048 + 1024 + h * 128, 2048, t0, nt, (char*)lds, r0, rpb + h * 465); }
    }
    SEAM(3);
    if (IN(4)) for (int rep_ = 0; rep_ < NREP(4); ++rep_) { if (rep_) GBAR();
        for (int m = gw; m < S; m += NGW) {
#pragma unroll
            for (int half = 0; half < 2; ++half) { bf16* rowp = MIX + (size_t)m * 2048 + half * 1024 + lane * 16; const float* gp = (half ? na_g : mla_g) + lane * 16;
                const bf16x8 a = *(const bf16x8*)rowp, b = *(const bf16x8*)(rowp + 8); float v[16]; float s = 0.f;
#pragma unroll
                for (int j = 0; j < 8; ++j) { v[j] = bf2f((unsigned short)a[j]); v[8 + j] = bf2f((unsigned short)b[j]); }
#pragma unroll
                for (int j = 0; j < 16; ++j) s += v[j] * v[j];
                const float rstd = 1.0f / sqrtf(wave_sum(s) * (1.f / 1024.f) + pg8::NORM_EPS);
                v4u o0, o1; const f32x4 g0 = *(const f32x4*)gp, g1 = *(const f32x4*)(gp + 4), g2 = *(const f32x4*)(gp + 8), g3 = *(const f32x4*)(gp + 12);
                o0.x = pk2(v[0] * rstd * g0[0], v[1] * rstd * g0[1]); o0.y = pk2(v[2] * rstd * g0[2], v[3] * rstd * g0[3]); o0.z = pk2(v[4] * rstd * g1[0], v[5] * rstd * g1[1]); o0.w = pk2(v[6] * rstd * g1[2], v[7] * rstd * g1[3]);
                o1.x = pk2(v[8] * rstd * g2[0], v[9] * rstd * g2[1]); o1.y = pk2(v[10] * rstd * g2[2], v[11] * rstd * g2[3]); o1.z = pk2(v[12] * rstd * g3[0], v[13] * rstd * g3[1]); o1.w = pk2(v[14] * rstd * g3[2], v[15] * rstd * g3[3]);
                *(v4u*)rowp = o0; *(v4u*)(rowp + 8) = o1; }
        }
    }
    SEAM(4);
    if (IN(5)) for (int rep_ = 0; rep_ < NREP(5); ++rep_) { if (rep_) GBAR();
        pg8::Gemm g{MIX, WOUT, S, DM, DM, DM, DM}; pg8::StaticOrder So; So.init(S, DM, G, bx);
        pg8::EpiRes<true> E{x, out, X1B, SSQ2};
        for (int i = 0; ; ++i) { pg8::Unit uu; if (!So.next(i, uu)) break; pg8::OneUnit O1{uu}; pg8::gemm_phase<pg8::EpiRes<true>, pg8::OneUnit, false, true>(ldsp, g, O1, E); }
    }
    SEAM(5);
    if (IN(6)) for (int rep_ = 0; rep_ < NREP(6); ++rep_) { if (rep_) GBAR();
        pg8::Gemm g{X1B, W1, S, DFF, DM, DM, DM}; pg8::StaticOrder So; So.init(S, DFF, G, bx);
        pg8::EpiFF1 E{U, SSQ2};
        pg8::gemm_phase<pg8::EpiFF1, pg8::StaticOrder, true, true>(ldsp, g, So, E);
    }
    SEAM(6);
    if (IN(7)) for (int rep_ = 0; rep_ < NREP(7); ++rep_) { if (rep_) GBAR();
        pg8::Gemm g{U, W2, S, DM, DFF, DFF, DFF}; pg8::StaticOrder So; So.init(S, DM, G, bx);
        pg8::EpiRes<false> E{out, out, nullptr, SSQ3};
        for (int i = 0; ; ++i) { pg8::Unit uu; if (!So.next(i, uu)) break; pg8::OneUnit O1{uu}; pg8::gemm_phase<pg8::EpiRes<false>, pg8::OneUnit, false, true>(ldsp, g, O1, E); }
    }
    SEAM(7);
    if (IN(8)) for (int rep_ = 0; rep_ < NREP(8); ++rep_) { if (rep_) GBAR();
        for (int m = gw; m < S; m += NGW) {
            const f32x4 sa = *(const f32x4*)(SSQ3 + (size_t)m * 8), sb = *(const f32x4*)(SSQ3 + (size_t)m * 8 + 4);
            const float rstd = 1.0f / sqrtf(((sa[0] + sa[1]) + (sa[2] + sa[3]) + (sb[0] + sb[1]) + (sb[2] + sb[3])) * (1.0f / 2048.0f) + pg8::NORM_EPS);
            f32x4* xr = (f32x4*)(out + (size_t)m * DM) + lane; const f32x4* gr = (const f32x4*)fin_g + lane;
#pragma unroll
            for (int j = 0; j < 8; ++j) { const f32x4 v = xr[64 * j], gg = gr[64 * j]; xr[64 * j] = v * rstd * gg; }
        }
    }
#undef IN
#undef SEAM
}

extern "C" void kernel_launch(void* const* d_in, const int* in_sizes, int n_in, void* d_out, int out_size, void* d_ws, size_t ws_size, hipStream_t stream) {
    static int grid = 0;
    if (grid == 0) {
        if (n_in != 15 || in_sizes[0] != S * DM || out_size != S * DM || ws_size < WS_END) { fprintf(stderr, "kernel_launch: unexpected shapes (n_in %d, in0 %d, out %d, ws %zu)\n", n_in, n_in > 0 ? in_sizes[0] : -1, out_size, ws_size); grid = -1; return; }
        int dev = 0, cus = 0, per_cu = 0;
        if (hipGetDevice(&dev) != hipSuccess || hipDeviceGetAttribute(&cus, hipDeviceAttributeMultiprocessorCount, dev) != hipSuccess) { grid = -1; return; }
        if (hipFuncSetAttribute((const void*)mk_fwd, hipFuncAttributeMaxDynamicSharedMemorySize, LDS_BYTES) != hipSuccess) { fprintf(stderr, "kernel_launch: hipFuncSetAttribute failed\n"); grid = -1; return; }
        if (hipOccupancyMaxActiveBlocksPerMultiprocessor(&per_cu, (const void*)mk_fwd, NWAVES * 64, LDS_BYTES) != hipSuccess || per_cu < 1) { fprintf(stderr, "kernel_launch: occupancy query failed (%d)\n", per_cu); (void)hipGetLastError(); per_cu = 1; }
        grid = cus * per_cu;
    }
    if (grid < 0) return;
    Args a{};
    for (int i = 0; i < 15; ++i) a.in[i] = (const float*)d_in[i];
    a.out = (float*)d_out; a.ws = (unsigned char*)d_ws;
#if MK_N_LAUNCHES == 1
    a.ph_lo = 0; a.ph_hi = N_PHASES;
    void* kargs[] = {&a};
    const hipError_t e = hipLaunchCooperativeKernel((const void*)mk_fwd, dim3(grid), dim3(NWAVES * 64), kargs, LDS_BYTES, stream);
    if (e != hipSuccess) fprintf(stderr, "kernel_launch: cooperative launch failed: %s (grid %d)\n", hipGetErrorString(e), grid);
#else
    for (int p = 0; p < N_PHASES; ++p) { a.ph_lo = p; a.ph_hi = p + 1; hipLaunchKernelGGL(mk_fwd, dim3(grid), dim3(NWAVES * 64), LDS_BYTES, stream, a); }
#endif
}
```
